# Optimizing an MI355X kernel written in HIP

```python
import jax
import jax.numpy as jnp
from jax import lax
import numpy as np

D_MODEL = 1024
BATCH = 8
SEQ = 4096
DEPTH = 2

HEAD_DIM = 64
NSA_HEADS = 8
NSA_KV_HEADS = 2
MOBA_HEADS = 8
ROPE_THETA = 10000.0
CMP_BLOCK = 32
CMP_STRIDE = 16
CMP_HIDDEN = 128
SEL_BLOCK = 64
SEL_TOPN = 16
WINDOW = 512
MOBA_BLOCK = 256
MOBA_TOPK = 3
N_EXPERTS = 256
TOP_K = 8
N_GROUPS = 8
TOPK_GROUPS = 4
D_EXPERT = 256
ROUTED_SCALE = 2.5
DISPATCH_ROWS = 128
SEL_QCHUNK = 64
WIN_QBLOCK = 128
MOBA_QCHUNK = 32
DEEPNORM_ALPHA = (2 * DEPTH) ** 0.25
DEEPNORM_BETA = (8 * DEPTH) ** -0.25
LN_EPS = 1e-5
NEG = -1e30
BIG = 1e30

NSA_Q = NSA_HEADS * HEAD_DIM
NSA_KV = NSA_KV_HEADS * HEAD_DIM
MOBA_W = MOBA_HEADS * HEAD_DIM
IN_SPLITS = (NSA_Q, NSA_KV, NSA_KV, NSA_KV, NSA_KV, NSA_KV, NSA_KV, 3 * NSA_HEADS, MOBA_W, MOBA_W, MOBA_W, D_MODEL, D_MODEL)
IN_COLS = sum(IN_SPLITS)
VALUE_SPLITS = (2, 4, 6, 10)

kernel_name = 'hybrid_nsa_moba_gated_deepnorm_moe'


def rope_tables(seq):
    pos = jnp.arange(seq, dtype=jnp.float32)
    inv = ROPE_THETA ** (-jnp.arange(0, HEAD_DIM, 2, dtype=jnp.float32) / HEAD_DIM)
    ang = pos[:, None] * inv[None, :]
    ang = jnp.concatenate([ang, ang], axis=-1)
    return jnp.cos(ang), jnp.sin(ang)


def apply_rope(t, cos, sin):
    t1, t2 = jnp.split(t, 2, axis=-1)
    rot = jnp.concatenate([-t2, t1], axis=-1)
    return (t * cos + rot * sin).astype(t.dtype)


def layer_norm(x, g, b):
    xf = x.astype(jnp.float32)
    mu = jnp.mean(xf, axis=-1, keepdims=True)
    var = jnp.mean(jnp.square(xf - mu), axis=-1, keepdims=True)
    return ((xf - mu) * lax.rsqrt(var + LN_EPS) * g + b).astype(x.dtype)


def _heads(t, n_heads):
    b, s, _ = t.shape
    return t.reshape(b, s, n_heads, HEAD_DIM).transpose(0, 2, 1, 3)


def _masked_softmax(scores, mask):
    return jax.nn.softmax(jnp.where(mask, scores.astype(jnp.float32), NEG), axis=-1)


def _gather_blocks(blocks, idx):
    return jax.vmap(jax.vmap(lambda bl, ix: bl[ix]))(blocks, idx)


def _unchunk(o):
    o = jnp.moveaxis(o, 0, -3)
    return o.reshape(o.shape[0], -1, o.shape[-3] * o.shape[-2], o.shape[-1])


def nsa_compress(t, pos_emb, w1, b1, w2):
    b, g, s, d = t.shape
    n_cmp = (s - CMP_BLOCK) // CMP_STRIDE + 1
    idx = np.arange(n_cmp)[:, None] * CMP_STRIDE + np.arange(CMP_BLOCK)[None, :]
    blocks = t[:, :, idx] + pos_emb
    hid = jax.nn.gelu(blocks.reshape(b, g, n_cmp, CMP_BLOCK * d) @ w1 + b1)
    return hid @ w2


def nsa_attention(q, q_rot, k_cmp, v_cmp, k_sel, v_sel, k_win, v_win, gates, cmp_pos, cmp_w1, cmp_b1, cmp_w2):
    b, h, s, d = q.shape
    g = NSA_KV_HEADS
    hg = h // g
    scale = d ** -0.5
    pos = jnp.arange(s)
    qg = q.reshape(b, g, hg, s, d)
    qr = q_rot.reshape(b, g, hg, s, d)

    kc = nsa_compress(k_cmp, cmp_pos[0], cmp_w1[0], cmp_b1[0], cmp_w2[0])
    vc = nsa_compress(v_cmp, cmp_pos[1], cmp_w1[1], cmp_b1[1], cmp_w2[1])
    n_cmp = kc.shape[2]
    cmp_mask = (jnp.arange(n_cmp) * CMP_STRIDE + CMP_BLOCK - 1)[None, :] <= pos[:, None]
    p_cmp = _masked_softmax(jnp.einsum('bghsd,bgnd->bghsn', qg, kc) * scale, cmp_mask)
    p_cmp = p_cmp * jnp.any(cmp_mask, axis=-1, keepdims=True)
    o_cmp = jnp.einsum('bghsn,bgnd->bghsd', p_cmp.astype(vc.dtype), vc).reshape(b, h, s, d)

    n_sel = s // SEL_BLOCK
    n_top = min(SEL_TOPN, n_sel)
    c0 = np.arange(n_cmp)[:, None] * CMP_STRIDE
    s0 = np.arange(n_sel)[None, :] * SEL_BLOCK
    overlap = np.clip(np.minimum(c0 + CMP_BLOCK, s0 + SEL_BLOCK) - np.maximum(c0, s0), 0, None) / CMP_STRIDE
    imp = jnp.einsum('bghsn,nj->bgsj', p_cmp, jnp.asarray(overlap, jnp.float32))
    blk = jnp.arange(n_sel)[None, :]
    cur = (pos // SEL_BLOCK)[:, None]
    forced = (blk == 0) | (blk == cur) | (blk == cur - 1)
    imp = jnp.where(forced, BIG, jnp.where(blk <= cur, imp, NEG))
    _, sel_idx = lax.top_k(imp, n_top)
    kb = k_sel.reshape(b, g, n_sel, SEL_BLOCK, d)
    vb = v_sel.reshape(b, g, n_sel, SEL_BLOCK, d)

    def sel_chunk(c):
        q0 = c * SEL_QCHUNK
        qc = lax.dynamic_slice_in_dim(qr, q0, SEL_QCHUNK, axis=3)
        ic = lax.dynamic_slice_in_dim(sel_idx, q0, SEL_QCHUNK, axis=2)
        kg = _gather_blocks(kb, ic).reshape(b, g, SEL_QCHUNK, n_top * SEL_BLOCK, d)
        vg = _gather_blocks(vb, ic).reshape(b, g, SEL_QCHUNK, n_top * SEL_BLOCK, d)
        kpos = (ic[..., None] * SEL_BLOCK + jnp.arange(SEL_BLOCK)).reshape(b, g, SEL_QCHUNK, n_top * SEL_BLOCK)
        qpos = q0 + jnp.arange(SEL_QCHUNK)
        mask = (kpos <= qpos[:, None])[:, :, None]
        p = _masked_softmax(jnp.einsum('bghqd,bgqkd->bghqk', qc, kg) * scale, mask)
        return jnp.einsum('bghqk,bgqkd->bghqd', p.astype(vg.dtype), vg)

    o_sel = _unchunk(lax.map(sel_chunk, jnp.arange(s // SEL_QCHUNK)))

    kw = jnp.pad(k_win, ((0, 0), (0, 0), (WINDOW, 0), (0, 0)))
    vw = jnp.pad(v_win, ((0, 0), (0, 0), (WINDOW, 0), (0, 0)))
    span = WINDOW + WIN_QBLOCK

    def win_block(c):
        q0 = c * WIN_QBLOCK
        qc = lax.dynamic_slice_in_dim(qr, q0, WIN_QBLOCK, axis=3)
        kc_ = lax.dynamic_slice_in_dim(kw, q0, span, axis=2)
        vc_ = lax.dynamic_slice_in_dim(vw, q0, span, axis=2)
        qpos = (q0 + jnp.arange(WIN_QBLOCK))[:, None]
        kpos = (q0 - WINDOW + jnp.arange(span))[None, :]
        mask = (kpos >= 0) & (kpos <= qpos) & (kpos > qpos - WINDOW)
        p = _masked_softmax(jnp.einsum('bghqd,bgkd->bghqk', qc, kc_) * scale, mask)
        return jnp.einsum('bghqk,bgkd->bghqd', p.astype(vc_.dtype), vc_)

    o_win = _unchunk(lax.map(win_block, jnp.arange(s // WIN_QBLOCK)))
    return gates[..., 0:1] * o_cmp + gates[..., 1:2] * o_sel + gates[..., 2:3] * o_win


def moba_attention(q, k, v):
    b, h, s, d = q.shape
    scale = d ** -0.5
    n_blk = -(-s // MOBA_BLOCK)
    s_pad = n_blk * MOBA_BLOCK
    pad = ((0, 0), (0, 0), (0, s_pad - s), (0, 0))
    q, k, v = jnp.pad(q, pad), jnp.pad(k, pad), jnp.pad(v, pad)
    kb = k.reshape(b, h, n_blk, MOBA_BLOCK, d)
    vb = v.reshape(b, h, n_blk, MOBA_BLOCK, d)
    kmean = jnp.mean(kb.astype(jnp.float32), axis=3).astype(k.dtype)
    cur = jnp.arange(s_pad) // MOBA_BLOCK
    past = jnp.arange(n_blk)[None, :] < cur[:, None]
    n_top = min(MOBA_TOPK, n_blk)
    gate = jnp.where(past, jnp.einsum('bhsd,bhnd->bhsn', q, kmean).astype(jnp.float32), NEG)
    _, top_idx = lax.top_k(gate, n_top)
    n_past = n_top * MOBA_BLOCK

    def chunk(c):
        q0 = c * MOBA_QCHUNK
        own0 = (q0 // MOBA_BLOCK) * MOBA_BLOCK
        qc = lax.dynamic_slice_in_dim(q, q0, MOBA_QCHUNK, axis=2)
        ic = lax.dynamic_slice_in_dim(top_idx, q0, MOBA_QCHUNK, axis=2)
        ok = jnp.repeat(ic < q0 // MOBA_BLOCK, MOBA_BLOCK, axis=-1)
        kg = _gather_blocks(kb, ic).reshape(b, h, MOBA_QCHUNK, n_past, d)
        vg = _gather_blocks(vb, ic).reshape(b, h, MOBA_QCHUNK, n_past, d)
        ko = lax.dynamic_slice_in_dim(k, own0, MOBA_BLOCK, axis=2)
        vo = lax.dynamic_slice_in_dim(v, own0, MOBA_BLOCK, axis=2)
        qpos = (q0 + jnp.arange(MOBA_QCHUNK))[:, None]
        kpos = (own0 + jnp.arange(MOBA_BLOCK))[None, :]
        s_past = jnp.where(ok, jnp.einsum('bhqd,bhqkd->bhqk', qc, kg).astype(jnp.float32) * scale, NEG)
        s_own = jnp.where(kpos <= qpos, jnp.einsum('bhqd,bhkd->bhqk', qc, ko).astype(jnp.float32) * scale, NEG)
        p = jax.nn.softmax(jnp.concatenate([s_past, s_own], axis=-1), axis=-1)
        return (jnp.einsum('bhqk,bhqkd->bhqd', p[..., :n_past].astype(vg.dtype), vg)
                + jnp.einsum('bhqk,bhkd->bhqd', p[..., n_past:].astype(vo.dtype), vo))

    o = _unchunk(lax.map(chunk, jnp.arange(s_pad // MOBA_QCHUNK)))
    return o[:, :, :s]


def hybrid_mixer(x, w_in, b_in, cmp_pos, cmp_w1, cmp_b1, cmp_w2, w_proj_a, w_proj_b, w_out, cos, sin):
    b, s, _ = x.shape
    proj = x @ w_in + b_in
    offs = np.cumsum(IN_SPLITS)[:-1].tolist()
    (qa, kca, vca, ksa, vsa, kwa, vwa, ga, qb, kb, vb, merge_a, merge_b) = jnp.split(proj, offs, axis=-1)
    qa = _heads(qa, NSA_HEADS)
    o_a = nsa_attention(
        qa, apply_rope(qa, cos, sin),
        _heads(kca, NSA_KV_HEADS), _heads(vca, NSA_KV_HEADS),
        apply_rope(_heads(ksa, NSA_KV_HEADS), cos, sin), _heads(vsa, NSA_KV_HEADS),
        apply_rope(_heads(kwa, NSA_KV_HEADS), cos, sin), _heads(vwa, NSA_KV_HEADS),
        jax.nn.sigmoid(ga.reshape(b, s, NSA_HEADS, 3).transpose(0, 2, 1, 3)),
        cmp_pos, cmp_w1, cmp_b1, cmp_w2)
    o_b = moba_attention(apply_rope(_heads(qb, MOBA_HEADS), cos, sin),
                         apply_rope(_heads(kb, MOBA_HEADS), cos, sin),
                         _heads(vb, MOBA_HEADS))
    o_a = o_a.transpose(0, 2, 1, 3).reshape(b, s, NSA_Q)
    o_b = o_b.transpose(0, 2, 1, 3).reshape(b, s, MOBA_W)
    merged = jax.nn.sigmoid(merge_a) * (o_a @ w_proj_a) + jax.nn.sigmoid(merge_b) * (o_b @ w_proj_b)
    return merged @ w_out


def moe_ffn(x, router_w, router_bias, w_gate, w_up, w_down, ws_gate, ws_up, ws_down):
    b, s, d = x.shape
    n_tok = b * s
    xf = x.reshape(n_tok, d)
    scores = jax.nn.sigmoid((xf @ router_w).astype(jnp.float32))
    biased = scores + router_bias.astype(jnp.float32)
    grp = biased.reshape(n_tok, N_GROUPS, N_EXPERTS // N_GROUPS)
    grp_score = jnp.sum(lax.top_k(grp, 2)[0], axis=-1)
    _, grp_idx = lax.top_k(grp_score, TOPK_GROUPS)
    grp_mask = jnp.any(grp_idx[..., None] == jnp.arange(N_GROUPS), axis=1)
    expert_mask = jnp.repeat(grp_mask, N_EXPERTS // N_GROUPS, axis=1)
    _, top_idx = lax.top_k(jnp.where(expert_mask, biased, NEG), TOP_K)
    top_s = jnp.take_along_axis(scores, top_idx, axis=-1)
    gate = top_s / jnp.sum(top_s, axis=-1, keepdims=True) * ROUTED_SCALE

    n_assign = n_tok * TOP_K
    e_flat = top_idx.reshape(n_assign)
    tok_flat = jnp.arange(n_assign, dtype=jnp.int32) // TOP_K
    order = jnp.argsort(e_flat)
    e_sorted = e_flat[order]
    counts = jnp.bincount(e_flat, length=N_EXPERTS)
    padded = (counts + DISPATCH_ROWS - 1) // DISPATCH_ROWS * DISPATCH_ROWS
    start = jnp.cumsum(counts) - counts
    pad_end = jnp.cumsum(padded)
    pad_start = pad_end - padded
    dest = pad_start[e_sorted] + jnp.arange(n_assign, dtype=jnp.int32) - start[e_sorted]
    n_blocks = -(-(n_assign + N_EXPERTS * (DISPATCH_ROWS - 1)) // DISPATCH_ROWS)
    n_rows = n_blocks * DISPATCH_ROWS
    row_tok = jnp.full((n_rows,), n_tok, jnp.int32).at[dest].set(tok_flat[order])
    row_gate = jnp.zeros((n_rows,), jnp.float32).at[dest].set(gate.reshape(n_assign)[order])
    blk_expert = jnp.minimum(jnp.searchsorted(pad_end, jnp.arange(n_blocks) * DISPATCH_ROWS, side='right'), N_EXPERTS - 1)
    x_pad = jnp.concatenate([xf, jnp.zeros((1, d), xf.dtype)], axis=0)

    def expert_block(args):
        rows, g, e = args
        xb = x_pad[rows]
        hb = jax.nn.silu(xb @ w_gate[e]) * (xb @ w_up[e])
        return (hb @ w_down[e]) * g[:, None].astype(xb.dtype)

    y_rows = lax.map(expert_block, (row_tok.reshape(n_blocks, DISPATCH_ROWS),
                                    row_gate.reshape(n_blocks, DISPATCH_ROWS), blk_expert))
    routed = jax.ops.segment_sum(y_rows.reshape(n_rows, d), row_tok, num_segments=n_tok + 1)[:n_tok]
    shared = (jax.nn.silu(xf @ ws_gate) * (xf @ ws_up)) @ ws_down
    return (routed + shared).reshape(b, s, d)


def setup_inputs(seed: int = 0) -> dict:
    key = jax.random.key(seed)
    ks = jax.random.split(key, 22)
    f32 = jnp.float32
    D, E, F, L = D_MODEL, N_EXPERTS, D_EXPERT, DEPTH

    def nrm(k, shape, scale):
        return jax.random.normal(k, shape, f32) * scale

    bounds = np.concatenate([[0], np.cumsum(IN_SPLITS)])
    col_scale = np.ones((IN_COLS,), np.float32)
    for i in VALUE_SPLITS:
        col_scale[bounds[i]:bounds[i + 1]] = DEEPNORM_BETA
    return {
        'x': nrm(ks[0], (BATCH, SEQ, D), 1.0),
        'w_in': nrm(ks[1], (L, D, IN_COLS), D ** -0.5) * jnp.asarray(col_scale),
        'b_in': nrm(ks[2], (L, IN_COLS), 0.02),
        'cmp_pos': nrm(ks[3], (L, 2, CMP_BLOCK, HEAD_DIM), 0.02),
        'cmp_w1': nrm(ks[4], (L, 2, CMP_BLOCK * HEAD_DIM, CMP_HIDDEN), (CMP_BLOCK * HEAD_DIM) ** -0.5),
        'cmp_b1': nrm(ks[5], (L, 2, CMP_HIDDEN), 0.02),
        'cmp_w2': nrm(ks[6], (L, 2, CMP_HIDDEN, HEAD_DIM), CMP_HIDDEN ** -0.5),
        'w_proj_a': nrm(ks[7], (L, NSA_Q, D), NSA_Q ** -0.5 * DEEPNORM_BETA),
        'w_proj_b': nrm(ks[8], (L, MOBA_W, D), MOBA_W ** -0.5 * DEEPNORM_BETA),
        'w_out': nrm(ks[9], (L, D, D), D ** -0.5 * DEEPNORM_BETA),
        'ln1_g': 1.0 + nrm(ks[10], (L, D), 0.02),
        'ln1_b': nrm(ks[11], (L, D), 0.02),
        'router_w': nrm(ks[12], (L, D, E), D ** -0.5),
        'router_bias': nrm(ks[13], (L, E), 0.01),
        'w_gate': nrm(ks[14], (L, E, D, F), D ** -0.5),
        'w_up': nrm(ks[15], (L, E, D, F), D ** -0.5),
        'w_down': nrm(ks[16], (L, E, F, D), F ** -0.5 * DEEPNORM_BETA),
        'ws_gate': nrm(ks[17], (L, D, F), D ** -0.5),
        'ws_up': nrm(ks[18], (L, D, F), D ** -0.5),
        'ws_down': nrm(ks[19], (L, F, D), F ** -0.5 * DEEPNORM_BETA),
        'ln2_g': 1.0 + nrm(ks[20], (L, D), 0.02),
        'ln2_b': nrm(ks[21], (L, D), 0.02),
    }


def reference(x, w_in, b_in, cmp_pos, cmp_w1, cmp_b1, cmp_w2, w_proj_a, w_proj_b, w_out, ln1_g, ln1_b,
              router_w, router_bias, w_gate, w_up, w_down, ws_gate, ws_up, ws_down, ln2_g, ln2_b):
    cos, sin = rope_tables(x.shape[1])
    for l in range(DEPTH):
        y = hybrid_mixer(x, w_in[l], b_in[l], cmp_pos[l], cmp_w1[l], cmp_b1[l], cmp_w2[l],
                         w_proj_a[l], w_proj_b[l], w_out[l], cos, sin)
        x = layer_norm(DEEPNORM_ALPHA * x + y, ln1_g[l], ln1_b[l])
        y = moe_ffn(x, router_w[l], router_bias[l], w_gate[l], w_up[l], w_down[l],
                    ws_gate[l], ws_up[l], ws_down[l])
        x = layer_norm(DEEPNORM_ALPHA * x + y, ln2_g[l], ln2_b[l])
    return x
```

```cpp
#include <hip/hip_runtime.h>
#include <stdint.h>
#include <stdio.h>

#ifndef PROBE_DUP
#define PROBE_DUP 0
#define NREP 10
#define PROBE_VAR 0
#endif
#ifndef MK_MULTI
#define MK_MULTI 0
#endif

#define DI __device__ __forceinline__
#define LAS __attribute__((address_space(3)))

typedef unsigned short bf16_t;
typedef short bf16x8 __attribute__((ext_vector_type(8)));
typedef short s16x4 __attribute__((ext_vector_type(4)));
typedef __bf16 bf16x2n __attribute__((ext_vector_type(2)));
typedef float f32x2 __attribute__((ext_vector_type(2)));
typedef float f32x4 __attribute__((ext_vector_type(4)));
typedef float f32x16 __attribute__((ext_vector_type(16)));
typedef unsigned u32x4 __attribute__((ext_vector_type(4)));
typedef unsigned u32x2 __attribute__((ext_vector_type(2)));

constexpr int D = 1024, NBATCH = 8, SEQ = 4096, NT = NBATCH * SEQ, NL = 2;
constexpr int IN_COLS = 4888, NP = 5120;
constexpr int NE = 256, DE = 256, TOPK = 8;
constexpr int MAXROWS = NT * TOPK + NE * 128;
constexpr int TOTROWS = MAXROWS + NT;
constexpr float ALPHA = 1.41421356237309515f;
constexpr float LN_EPS = 1e-5f;
constexpr float SM_C = 0.125f * 1.44269504088896341f;
constexpr float NEGF = -1e30f, BIGF = 1e30f;

enum { I_X = 0, I_WIN, I_BIN, I_CPOS, I_CW1, I_CB1, I_CW2, I_WPA, I_WPB, I_WOUT, I_LN1G, I_LN1B, I_RW, I_RB, I_WG, I_WU, I_WD, I_SG, I_SU, I_SD, I_LN2G, I_LN2B };

struct Params { const float* in[22]; float* out; char* ws; };

constexpr size_t al256(size_t x) { return (x + 255) & ~(size_t)255; }
constexpr size_t O_BAR = 0;
constexpr size_t O_CNT = 16384;
constexpr size_t O_MISC = 20480;
constexpr size_t ZERO_BYTES = 32768;
constexpr size_t O_COS = 32768;
constexpr size_t O_SIN = O_COS + (size_t)SEQ * 32 * 4;
constexpr size_t O_BIASP = O_SIN + (size_t)SEQ * 32 * 4;
constexpr size_t O_C1 = O_BIASP + al256((size_t)NL * NP * 4);
constexpr size_t O_C1PART = O_C1 + al256((size_t)NL * 2 * 128 * 4);
constexpr size_t O_WIN = O_C1PART + (size_t)NL * 2 * 64 * 128 * 4;
constexpr size_t O_WPA = O_WIN + (size_t)NL * NP * D * 2;
constexpr size_t O_WPB = O_WPA + (size_t)NL * D * 512 * 2;
constexpr size_t O_WOUT = O_WPB + (size_t)NL * D * 512 * 2;
constexpr size_t O_WR = O_WOUT + (size_t)NL * D * D * 2;
constexpr size_t O_W1 = O_WR + (size_t)NL * NE * D * 2;
constexpr size_t O_W2 = O_W1 + (size_t)NL * 2 * 128 * 2048 * 2;
constexpr size_t O_WSGU = O_W2 + (size_t)NL * 2 * 128 * 128 * 2;
constexpr size_t O_WSD = O_WSGU + (size_t)NL * 512 * D * 2;
constexpr size_t O_WGU = O_WSD + (size_t)NL * D * DE * 2;
constexpr size_t O_WDN = O_WGU + (size_t)NE * 512 * D * 2;
constexpr size_t O_XB0 = O_WDN + (size_t)NE * D * DE * 2;
constexpr size_t O_XB1 = O_XB0 + (size_t)NT * D * 2;
constexpr size_t O_XF1 = O_XB1 + (size_t)NT * D * 2;
constexpr size_t O_XF2 = O_XF1 + (size_t)NT * D * 4;
constexpr size_t O_LOGIT = O_XF2 + (size_t)NT * D * 4;
#ifndef F8_P1
#define F8_P1 1
#define F8_P5 1
#define F8_P6 1
#define F8_M1 1
#define F8_M2 1
#endif
constexpr size_t O_XA8 = O_XF1;
constexpr size_t O_OA8 = O_XF2;
constexpr size_t O_OB8 = O_OA8 + (size_t)NT * 512;
constexpr size_t O_MG8 = O_OB8 + (size_t)NT * 512;
constexpr float XS8 = 4.f, WS8 = 64.f, OS8 = 32.f, MS8 = 64.f, HS8 = 8.f;
constexpr size_t O_TOPI = O_LOGIT + (size_t)NT * NE * 4;
constexpr size_t O_GATE = O_TOPI + (size_t)NT * TOPK * 4;
constexpr size_t O_POS = O_GATE + (size_t)NT * TOPK * 4;
constexpr size_t O_SLOT = O_POS + (size_t)NT * TOPK * 4;
constexpr size_t O_ROWTOK = O_SLOT + (size_t)NT * TOPK * 4;
constexpr size_t O_TILEE = O_ROWTOK + al256((size_t)(MAXROWS + 256) * 4);
constexpr size_t O_H = O_TILEE + al256((size_t)3 * 1408 * 4);
constexpr size_t O_R = O_H + (size_t)TOTROWS * DE * 2;
constexpr size_t R_QA = 0;
constexpr size_t R_QAR = R_QA + (size_t)NT * 512 * 2;
constexpr size_t R_KC = R_QAR + (size_t)NT * 512 * 2;
constexpr size_t R_VC = R_KC + (size_t)NT * 128 * 2 + 4096;
constexpr size_t R_KS = R_VC + (size_t)NT * 128 * 2 + 4096;
constexpr size_t R_VS = R_KS + (size_t)NT * 128 * 2;
constexpr size_t R_KW = R_VS + (size_t)NT * 128 * 2;
constexpr size_t R_VW = R_KW + (size_t)NT * 128 * 2;
constexpr size_t R_QB = R_VW + (size_t)NT * 128 * 2;
constexpr size_t R_KB = R_QB + (size_t)NT * 512 * 2;
constexpr size_t R_VB = R_KB + (size_t)NT * 512 * 2;
constexpr size_t R_MA = R_VB + (size_t)NT * 512 * 2;
constexpr size_t R_MB = R_MA + (size_t)NT * D * 2;
constexpr size_t R_GA = R_MB + (size_t)NT * D * 2;
constexpr size_t R_OA = R_GA + (size_t)NT * 24 * 4;
constexpr size_t R_OB = R_OA + (size_t)NT * 512 * 2;
constexpr size_t R_MERGED = R_OB + (size_t)NT * 512 * 2;
constexpr size_t R_YPRE = R_MERGED + (size_t)NT * D * 2;
constexpr size_t R_HID = R_YPRE + (size_t)NT * D * 4;
constexpr size_t R_KCC = R_HID + (size_t)2 * 16 * 256 * 128 * 2;
constexpr size_t R_VCC = R_KCC + (size_t)16 * 256 * 64 * 2;
constexpr size_t R_KMEAN = R_VCC + (size_t)16 * 256 * 64 * 2;
constexpr size_t R_MIXEND = R_KMEAN + (size_t)64 * 16 * 64 * 4;
constexpr size_t R_YROWS_BYTES = (size_t)TOTROWS * D;
constexpr size_t R_BYTES = R_MIXEND > R_YROWS_BYTES ? R_MIXEND : R_YROWS_BYTES;
constexpr size_t WS_NEED = O_R + R_BYTES;
static_assert(WS_NEED < (size_t)1780 * 1000 * 1000, "workspace too large");

constexpr int LDS_BYTES = 128 * 1024;
constexpr int NTHREADS = 512;

DI int opaque_tid() { int t = threadIdx.x; asm volatile("" : "+v"(t)); return t; }
DI unsigned pk2(float lo, float hi) { f32x2 a = {lo, hi}; return __builtin_bit_cast(unsigned, __builtin_convertvector(a, bf16x2n)); }
DI float bf2f(unsigned short v) { return __uint_as_float(((unsigned)v) << 16); }
DI float fexp2(float x) { return __builtin_amdgcn_exp2f(x); }
DI float frcp(float x) { return __builtin_amdgcn_rcpf(x); }
DI float sigmoidf_(float x) { return frcp(1.0f + __expf(-x)); }
DI float shx(float v, int m) { return __shfl_xor(v, m); }
DI float max3f(float a, float b, float c) { float r; asm("v_max3_f32 %0, %1, %2, %3" : "=v"(r) : "v"(a), "v"(b), "v"(c)); return r; }
DI f32x16 mfma32(bf16x8 a, bf16x8 b, f32x16 c) { return __builtin_amdgcn_mfma_f32_32x32x16_bf16(a, b, c, 0, 0, 0); }
DI f32x4 mfma16(bf16x8 a, bf16x8 b, f32x4 c) { return __builtin_amdgcn_mfma_f32_16x16x32_bf16(a, b, c, 0, 0, 0); }
typedef int i32x4 __attribute__((ext_vector_type(4)));
typedef int i32x8 __attribute__((ext_vector_type(8)));
DI float clamp8(float v) { return __builtin_amdgcn_fmed3f(v, -448.f, 448.f); }
DI unsigned pk4_fp8(float a, float b, float c, float d) { int w = 0; w = __builtin_amdgcn_cvt_pk_fp8_f32(clamp8(a), clamp8(b), w, false); w = __builtin_amdgcn_cvt_pk_fp8_f32(clamp8(c), clamp8(d), w, true); return (unsigned)w; }
DI u32x4 widen16(u32x2 a, u32x2 b) {
    const auto r0 = __builtin_amdgcn_permlane16_swap(a.x, b.x, false, false);
    const auto r1 = __builtin_amdgcn_permlane16_swap(a.y, b.y, false, false);
    u32x4 o; o.x = r0[0]; o.y = r1[0]; o.z = r0[1]; o.w = r1[1]; return o;
}
DI int projmap2(int n) {
    const int tl = n >> 8, w = n & 255;
    if (tl >= 11) { if (tl < 19) return ((w < 128) ? 2840 : 3864) + (tl - 11) * 128 + (w & 127);
        return w < 24 ? 1280 + w : -1; }
    const int hd = (w >> 5) & 3, d = ((w >> 7) << 5) + (w & 31);
    if (tl < 2) return (4 * tl + hd) * 64 + d;
    if (tl < 5) { const int base = 512 + (tl - 2) * 256; return base + hd * 64 + d; }
    const int sec = (tl - 5) >> 1; return 1304 + sec * 512 + (4 * ((tl - 5) & 1) + hd) * 64 + d;
}
DI int projmap(int n) { return n < 1280 ? n : (n < 4864 ? n + 24 : (n < 4888 ? n - 4864 + 1280 : -1)); }

#define XB_TMO      128
#define XB_XCNT(j)  (256  + 64 * (j))
#define XB_XSUB(j)  (1280 + 64 * (j))
#define XB_XGEN(j)  (2304 + 64 * (j))
#define XB_TOP      3328
#define XB_TOPGEN   3392
#define XCD_BAR_WORDS 3456
#define XB_SPIN_CAP (1u << 22)
DI unsigned xb_ld(unsigned* p)              { return __hip_atomic_load(p, __ATOMIC_RELAXED, __HIP_MEMORY_SCOPE_AGENT); }
DI unsigned xb_add(unsigned* p, unsigned v) { return __hip_atomic_fetch_add(p, v, __ATOMIC_RELAXED, __HIP_MEMORY_SCOPE_AGENT); }
DI unsigned xb_xcc_id() { return (unsigned)__builtin_amdgcn_s_getreg((3 << 11) | 20) & 0xFu; }
#define XB_SPIN(cond, bar) do { unsigned _sp = 0; while (cond) { __builtin_amdgcn_s_sleep(1); \
    if ((++_sp & 255u) == 0u) { if (xb_ld(&(bar)[XB_TMO])) break; if (_sp > XB_SPIN_CAP) { atomicAdd(&(bar)[XB_TMO], 1u); break; } } } } while (0)
struct XcdBarrier { unsigned* bar; unsigned x; volatile LAS unsigned* st; };
DI XcdBarrier xcd_barrier_post(unsigned* bar, volatile LAS unsigned* st) {
    XcdBarrier b; b.bar = bar; b.x = xb_xcc_id(); b.st = st;
    if (opaque_tid() == 0) (void)xb_add(&bar[XB_XCNT(b.x)], 1u);
    return b;
}
DI void xcd_barrier_complete(unsigned* bar, unsigned x, unsigned& nloc, unsigned& nx) {
    const unsigned G = gridDim.x * gridDim.y * gridDim.z;
    unsigned sum, cnt, mine, sp = 0u;
    for (;;) {
        sum = 0u; cnt = 0u; mine = 0u;
#pragma unroll
        for (unsigned j = 0; j < 16; ++j) { const unsigned c = xb_ld(&bar[XB_XCNT(j)]); sum += c; cnt += (c > 0u) ? 1u : 0u; mine = (j == x) ? c : mine; }
        if (sum == G) break;
        __builtin_amdgcn_s_sleep(1);
        if ((++sp & 255u) == 0u) { if (xb_ld(&bar[XB_TMO])) break; if (sp > XB_SPIN_CAP) { atomicAdd(&bar[XB_TMO], 1u); break; } }
    }
    nloc = mine > 0u ? mine : 1u; nx = cnt > 0u ? cnt : 1u;
}
DI void xcd_barrier(const XcdBarrier& b) {
    asm volatile("s_waitcnt vmcnt(0)" ::: "memory");
    __syncthreads();
    if (opaque_tid() == 0) {
        unsigned* bar = b.bar; const unsigned bx = xb_xcc_id();
        __builtin_amdgcn_s_waitcnt(0);
        unsigned nloc = b.st[0], nx = b.st[1];
        if (nloc == 0u) { xcd_barrier_complete(bar, bx, nloc, nx); b.st[0] = nloc; b.st[1] = nx; }
        const unsigned old = xb_add(&bar[XB_XSUB(bx)], 1u);
        const unsigned gen = old / nloc;
        if (old + 1u == (gen + 1u) * nloc) {
            __builtin_amdgcn_fence(__ATOMIC_RELEASE, "agent");
            asm volatile("s_waitcnt vmcnt(0)" ::: "memory");
            const unsigned og = xb_add(&bar[XB_TOP], 1u);
            const unsigned tg = og / nx;
            if (og + 1u == (tg + 1u) * nx) xb_add(&bar[XB_TOPGEN], 1u);
            else XB_SPIN(xb_ld(&bar[XB_TOPGEN]) == tg, bar);
            __builtin_amdgcn_fence(__ATOMIC_ACQUIRE, "agent");
            xb_add(&bar[XB_XGEN(bx)], 1u);
            asm volatile("s_waitcnt vmcnt(0)" ::: "memory");
        } else {
            XB_SPIN(xb_ld(&bar[XB_XGEN(bx)]) == gen, bar);
            __builtin_amdgcn_fence(__ATOMIC_ACQUIRE, "agent");
            asm volatile("s_waitcnt vmcnt(0)" ::: "memory");
        }
    }
    __syncthreads();
}

DI void stage_rc(int b, int& R, int& C) { const int st = b >> 10, sb = b & 1023, swz = sb ^ (((sb >> 9) & 1) << 5); R = (st >> 1) * 16 + (swz >> 6); C = (st & 1) * 32 + ((swz & 63) >> 1); }

template <int WM, int WN>
DI void gemm_kloop(f32x4 (&acc)[4][4], const bf16_t* (&ap)[WM], const bf16_t* (&bp)[WN], int nkt, LAS char* lds, int tid) {
    constexpr int AB = WM * 8192, BB = WN * 8192, ST = AB + BB;
    const int lane = tid & 63, wid = tid >> 6, wm = wid / WN, wn = wid % WN, fr = lane & 15, fq = lane >> 4;
    const int loff = (fr * 64 + fq * 16) ^ ((fr >> 3) << 5);
    u32x4 ra[WM], rb[WN];
#pragma unroll
    for (int i = 0; i < WM; ++i) ra[i] = *(const u32x4*)(ap[i]);
#pragma unroll
    for (int i = 0; i < WN; ++i) rb[i] = *(const u32x4*)(bp[i]);
#pragma unroll
    for (int i = 0; i < WM; ++i) *(LAS u32x4*)(lds + tid * 16 + 8192 * i) = ra[i];
#pragma unroll
    for (int i = 0; i < WN; ++i) *(LAS u32x4*)(lds + AB + tid * 16 + 8192 * i) = rb[i];
    __syncthreads();
    for (int kt = 0; kt < nkt; ++kt) {
        LAS char* cur = lds + (kt & 1) * ST;
        LAS char* nxt = lds + ((kt + 1) & 1) * ST;
        const bool more = kt + 1 < nkt;
        if (more) {
#pragma unroll
            for (int i = 0; i < WM; ++i) ra[i] = *(const u32x4*)(ap[i] + (size_t)(kt + 1) * 64);
#pragma unroll
            for (int i = 0; i < WN; ++i) rb[i] = *(const u32x4*)(bp[i] + (size_t)(kt + 1) * 64);
        }
#pragma unroll
        for (int kh = 0; kh < 2; ++kh) {
            bf16x8 af[4], bg[4];
#pragma unroll
            for (int m = 0; m < 4; ++m) af[m] = *(LAS const bf16x8*)(cur + (2 * (4 * wm + m) + kh) * 1024 + loff);
#pragma unroll
            for (int n = 0; n < 4; ++n) bg[n] = *(LAS const bf16x8*)(cur + AB + (2 * (4 * wn + n) + kh) * 1024 + loff);
#pragma unroll
            for (int m = 0; m < 4; ++m)
#pragma unroll
                for (int n = 0; n < 4; ++n) acc[m][n] = mfma16(bg[n], af[m], acc[m][n]);
        }
        if (more) {
#pragma unroll
            for (int i = 0; i < WM; ++i) *(LAS u32x4*)(nxt + tid * 16 + 8192 * i) = ra[i];
#pragma unroll
            for (int i = 0; i < WN; ++i) *(LAS u32x4*)(nxt + AB + tid * 16 + 8192 * i) = rb[i];
        }
        __syncthreads();
    }
}
DI void zero_acc(f32x4 (&acc)[4][4]) {
#pragma unroll
    for (int m = 0; m < 4; ++m)
#pragma unroll
        for (int n = 0; n < 4; ++n) acc[m][n] = (f32x4){0.f, 0.f, 0.f, 0.f};
}
DI void st_bf16x4(bf16_t* p, f32x4 v) { u32x2 w; w.x = pk2(v[0], v[1]); w.y = pk2(v[2], v[3]); *(u32x2*)p = w; }
#ifndef EPI_NT
#define EPI_NT 0
#endif
DI void st_bf16x4e(bf16_t* p, f32x4 v) { u32x2 w; w.x = pk2(v[0], v[1]); w.y = pk2(v[2], v[3]); if (EPI_NT) __builtin_nontemporal_store(w, (u32x2*)p); else *(u32x2*)p = w; }
DI void st_f32x4e(float* p, f32x4 v) { if (EPI_NT) __builtin_nontemporal_store(v, (f32x4*)p); else *(f32x4*)p = v; }

struct TrJob { const float* s0; const float* s1; int src_ld; int nsrc; bf16_t* dst; int K; int mode; };
DI void tr_tiles4x(const float* js0, const float* js1, int jsrc_ld, int jnsrc, bf16_t* jdst, int jK, int jmode, int k0, int n0, LAS char* lds, int tid) {
    LAS float* T = (LAS float*)lds;
#pragma unroll
    for (int q = 0; q < 4; ++q) {
        const int nn = tid & 63, n = n0 + q * 64 + nn;
        const float* sp; int col;
        if (jmode == 2) { const int tl = n >> 8, w = n & 255; sp = (w < 128) ? js0 : js1; col = tl * 128 + (w & 127); }
        else if (jmode == 1) { sp = js0; col = projmap2(n); }
        else { sp = js0; col = (n < jnsrc) ? n : -1; }
#pragma unroll
        for (int i = 0; i < 8; ++i) {
            const int kk = (tid >> 6) + 8 * i;
            const float v = (col >= 0) ? sp[(size_t)(k0 + kk) * jsrc_ld + col] : 0.f;
            T[(q * 64 + kk) * 65 + nn] = v;
        }
    }
    __syncthreads();
#pragma unroll
    for (int q = 0; q < 4; ++q) {
        const int nn = tid >> 3, kc = tid & 7;
        float v[8];
#pragma unroll
        for (int i = 0; i < 8; ++i) v[i] = T[(q * 64 + kc * 8 + i) * 65 + nn];
        u32x4 w; w.x = pk2(v[0], v[1]); w.y = pk2(v[2], v[3]); w.z = pk2(v[4], v[5]); w.w = pk2(v[6], v[7]);
        *(u32x4*)(jdst + (size_t)(n0 + q * 64 + nn) * jK + k0 + kc * 8) = w;
    }
    __syncthreads();
}
DI void tr_tiles4(const TrJob& j, int k0, int n0, LAS char* lds, int tid) { tr_tiles4x(j.s0, j.s1, j.src_ld, j.nsrc, j.dst, j.K, j.mode, k0, n0, lds, tid); }
DI void tr_job_run(const TrJob& j, int Nd, int first, int stride, LAS char* lds, int tid) {
    const int ng = Nd / 256, nk = j.K / 64;
    for (int u = first; u < ng * nk; u += stride) { const int gk = u % nk, gn = u / nk; tr_tiles4(j, gk * 64, gn * 256, lds, tid); }
}
DI void moe_weight_convert(const Params& p, int l, LAS char* lds, int tid) {
    const float* wg = p.in[I_WG] + (size_t)l * NE * D * DE; const float* wu = p.in[I_WU] + (size_t)l * NE * D * DE; const float* wd = p.in[I_WD] + (size_t)l * NE * DE * D;
    bf16_t* WGU = (bf16_t*)(p.ws + O_WGU); bf16_t* WDN = (bf16_t*)(p.ws + O_WDN);
    for (int u = blockIdx.x; u < NE * 48; u += gridDim.x) {
        const int e = u / 48, it = u % 48;
        if (it < 32) tr_tiles4x(wg + (size_t)e * D * DE, wu + (size_t)e * D * DE, DE, DE, WGU + (size_t)e * 512 * D, D, 2, (it & 15) * 64, (it >> 4) * 256, lds, tid);
        else { const int i2 = it - 32; tr_tiles4x(wd + (size_t)e * DE * D, nullptr, D, D, WDN + (size_t)e * D * DE, DE, 0, (i2 & 3) * 64, (i2 >> 2) * 256, lds, tid); }
    }
}

DI void conv_decode(const Params& p, int set, int idx, const float*& s0, const float*& s1, char*& dst, int& src_ld, int& K, int& mode, int& k0, int& n0, int& f8) {
    char* ws = p.ws; s1 = nullptr; f8 = 0;
    int r = idx;
    if (set == 0 && r < 1024) {
        if (r < 640) { const int l = r / 320; r %= 320; s0 = p.in[I_WIN] + (size_t)l * D * IN_COLS; src_ld = IN_COLS; f8 = F8_P1; dst = ws + O_WIN + (size_t)l * NP * D * (F8_P1 ? 1 : 2); K = D; mode = 1; n0 = (r >> 4) * 256; k0 = (r & 15) * 64; return; }
        r -= 640;
        if (r < 128) { const int ab = r >> 6; r &= 63; const int l = r >> 5; r &= 31; s0 = p.in[ab ? I_WPB : I_WPA] + (size_t)l * 512 * D; src_ld = D; f8 = F8_P5; dst = ws + (ab ? O_WPB : O_WPA) + (size_t)l * D * 512 * (F8_P5 ? 1 : 2); K = 512; mode = 0; n0 = (r >> 3) * 256; k0 = (r & 7) * 64; return; }
        r -= 128;
        if (r < 128) { const int l = r >> 6; r &= 63; s0 = p.in[I_WOUT] + (size_t)l * D * D; src_ld = D; f8 = F8_P6; dst = ws + O_WOUT + (size_t)l * D * D * (F8_P6 ? 1 : 2); K = D; mode = 0; n0 = (r >> 4) * 256; k0 = (r & 15) * 64; return; }
        r -= 128;
        if (r < 32) { const int l = r >> 4; r &= 15; s0 = p.in[I_RW] + (size_t)l * D * NE; src_ld = NE; dst = ws + O_WR + (size_t)l * NE * D * 2; K = D; mode = 0; n0 = 0; k0 = r * 64; return; }
        r -= 32;
        if (r < 64) { const int l = r >> 5; r &= 31; s0 = p.in[I_SG] + (size_t)l * D * DE; s1 = p.in[I_SU] + (size_t)l * D * DE; src_ld = DE; f8 = F8_M1; dst = ws + O_WSGU + (size_t)l * 512 * D * (F8_M1 ? 1 : 2); K = D; mode = 2; n0 = (r >> 4) * 256; k0 = (r & 15) * 64; return; }
        r -= 64;
        { const int l = r >> 4; r &= 15; s0 = p.in[I_SD] + (size_t)l * DE * D; src_ld = D; f8 = F8_M2; dst = ws + O_WSD + (size_t)l * D * DE * (F8_M2 ? 1 : 2); K = DE; mode = 0; n0 = (r >> 2) * 256; k0 = (r & 3) * 64; return; }
    }
    const int l = set; if (set == 0) r -= 1024;
    const int e = r / 48, it = r % 48;
    if (it < 32) { s0 = p.in[I_WG] + ((size_t)l * NE + e) * D * DE; s1 = p.in[I_WU] + ((size_t)l * NE + e) * D * DE; src_ld = DE; f8 = F8_M1; dst = ws + O_WGU + ((size_t)l * NE + e) * 512 * D; K = D; mode = 2; n0 = (it >> 4) * 256; k0 = (it & 15) * 64; }
    else { const int i2 = it - 32; s0 = p.in[I_WD] + ((size_t)l * NE + e) * DE * D; src_ld = D; f8 = F8_M2; dst = ws + O_WDN + ((size_t)l * NE + e) * D * DE; K = DE; mode = 0; n0 = (i2 >> 2) * 256; k0 = (i2 & 3) * 64; }
}
DI void conv_loads(f32x4 (&r)[8], const float* s0, const float* s1, int src_ld, int mode, int k0, int n0, int tid) {
    const int n = n0 + 4 * (tid & 63);
    const float* sp; bool ok = true;
    if (mode == 2) { const int tl = n >> 8, w = n & 255; sp = ((w < 128) ? s0 : s1) + tl * 128 + (w & 127); }
    else if (mode == 1) { const int c = projmap2(n); ok = c >= 0; sp = s0 + (ok ? c : 0); }
    else sp = s0 + n;
    sp += (size_t)(k0 + (tid >> 6)) * src_ld;
#pragma unroll
    for (int j = 0; j < 8; ++j) r[j] = ok ? *(const f32x4*)(sp + (size_t)(8 * j) * src_ld) : (f32x4){0.f, 0.f, 0.f, 0.f};
}
struct ConvItem { const float* s0; const float* s1; char* dst; int src_ld, K, mode, k0, n0, f8; };
DI void conv_item(const Params& p, int set, int idx, ConvItem& c) { conv_decode(p, set, idx, c.s0, c.s1, c.dst, c.src_ld, c.K, c.mode, c.k0, c.n0, c.f8); }
DI void conv_img_write(LAS char* img, const f32x4 (&r)[8], int tid) {
#pragma unroll
    for (int j = 0; j < 8; ++j) { u32x2 v; v.x = pk2(r[j][0], r[j][1]); v.y = pk2(r[j][2], r[j][3]); *(LAS u32x2*)(img + ((tid >> 6) + 8 * j) * 576 + (tid & 63) * 8) = v; }
}
DI void conv_emit(const ConvItem& c, LAS const char* img, int tid, int nostore = 0) {
    const int lane = tid & 63, w = tid >> 6, G = lane >> 4, i16 = lane & 15, q = i16 >> 2, pp = i16 & 3;
#pragma unroll
    for (int s = 0; s < 4; ++s) {
        const int combo = s * 8 + w, nb = 2 * (combo >> 2) + (G & 1), kc = 2 * (combo & 3) + (G >> 1);
        LAS const char* a = img + (8 * kc + q) * 576 + (16 * nb + 4 * pp) * 2;
        const s16x4 lo = __builtin_amdgcn_ds_read_tr16_b64_v4i16((LAS s16x4*)a);
        const s16x4 hi = __builtin_amdgcn_ds_read_tr16_b64_v4i16((LAS s16x4*)(a + 4 * 576));
        const bf16x8 o = __builtin_shufflevector(lo, hi, 0, 1, 2, 3, 4, 5, 6, 7);
        const size_t eo = (size_t)(c.n0 + 16 * nb + i16) * c.K + c.k0 + 8 * kc;
        if (c.f8) { float f[8];
#pragma unroll
            for (int j = 0; j < 8; ++j) f[j] = bf2f((unsigned short)o[j]) * WS8;
            u32x2 w8; w8.x = pk4_fp8(f[0], f[1], f[2], f[3]); w8.y = pk4_fp8(f[4], f[5], f[6], f[7]); if (!nostore) *(u32x2*)(c.dst + eo) = w8; else asm volatile("" :: "v"(w8)); }
        else if (!nostore) *(bf16x8*)(c.dst + eo * 2) = o; else asm volatile("" :: "v"(o));
    }
}
DI void conv_stream(const Params& p, int set, int total, LAS char* lds, int tid, int nostore = 0) {
    int idxA = 2 * blockIdx.x; const int stride = 2 * gridDim.x;
    __syncthreads();
    if (idxA >= total) return;
    ConvItem A, B, A2, B2; f32x4 rA[8], rB[8];
    conv_item(p, set, idxA, A); conv_loads(rA, A.s0, A.s1, A.src_ld, A.mode, A.k0, A.n0, tid);
    int idxB = idxA + 1; bool hasB = idxB < total;
    B = A; if (hasB) { conv_item(p, set, idxB, B); conv_loads(rB, B.s0, B.s1, B.src_ld, B.mode, B.k0, B.n0, tid); }
    LAS char* img0 = lds; LAS char* img1 = lds + 36864;
    for (;;) {
        conv_img_write(img0, rA, tid);
        __syncthreads();
        const int idxA2 = idxA + stride; const bool hasA2 = idxA2 < total;
        A2 = A; if (hasA2) { conv_item(p, set, idxA2, A2); conv_loads(rA, A2.s0, A2.s1, A2.src_ld, A2.mode, A2.k0, A2.n0, tid); }
        conv_emit(A, img0, tid, nostore);
        if (!hasB) break;
        conv_img_write(img1, rB, tid);
        __syncthreads();
        const int idxB2 = idxB + stride; const bool hasB2 = idxB2 < total;
        B2 = B; if (hasB2) { conv_item(p, set, idxB2, B2); conv_loads(rB, B2.s0, B2.s1, B2.src_ld, B2.mode, B2.k0, B2.n0, tid); }
        conv_emit(B, img1, tid, nostore);
        if (!hasA2) break;
        A = A2; B = B2; idxA = idxA2; idxB = idxB2; hasB = hasB2;
    }
    __syncthreads();
}
constexpr int NQ0 = NE * 48, NQ = 2 * NQ0;
constexpr size_t O_WQ = O_MISC + 1024;
DI void conv_pair(const Params& p, int q, LAS char* lds, int tid) {
    const int set = q >= NQ0 ? 1 : 0, i0 = set ? q - NQ0 : 1024 + q;
    ConvItem A; f32x4 rA[8];
    conv_item(p, set, i0, A); conv_loads(rA, A.s0, A.s1, A.src_ld, A.mode, A.k0, A.n0, tid);
    conv_img_write(lds, rA, tid);
    __syncthreads();
    conv_emit(A, lds, tid);
    __syncthreads();
}
DI void conv_drain(const Params& p, int limit, LAS char* lds, volatile LAS unsigned* st, int tid) {
    __syncthreads();
    for (;;) {
        if (tid == 0) st[3] = (st[3] == 0xffffffffu) ? 0xffffffffu : atomicAdd((unsigned*)(p.ws + O_WQ), 1u);
        __syncthreads();
        unsigned q = st[3];
        __syncthreads();
        if (q >= (unsigned)NQ) { if (tid == 0) st[3] = 0xffffffffu; break; }
        conv_pair(p, (int)q, lds, tid);
        if (q >= (unsigned)limit) break;
    }
    __syncthreads();
}
DI void phase_prologue(const Params& p, LAS char* lds) {
    const int tid = opaque_tid();
    const size_t gtid = (size_t)blockIdx.x * NTHREADS + tid, gstride = (size_t)gridDim.x * NTHREADS;
    char* ws = p.ws;
    { float* COS = (float*)(ws + O_COS); float* SIN = (float*)(ws + O_SIN);
      for (size_t i = gtid; i < (size_t)SEQ * 32; i += gstride) {
          const int s = (int)(i >> 5), d = (int)(i & 31);
          const float inv = exp2f(-(float)d * (13.287712379549449f / 32.0f));
          const float ang = (float)s * inv;
          const double rev = (double)ang * 0.15915494309189535;
          const double fr = rev - floor(rev);
          COS[i] = __builtin_amdgcn_cosf((float)fr); SIN[i] = __builtin_amdgcn_sinf((float)fr);
      } }
    { float* BP = (float*)(ws + O_BIASP);
      for (size_t i = gtid; i < (size_t)NL * NP; i += gstride) { const int l = (int)(i / NP), n = (int)(i % NP); const int c = projmap2(n); BP[i] = c >= 0 ? p.in[I_BIN][(size_t)l * IN_COLS + c] : 0.f; } }
    { float* PART = (float*)(ws + O_C1PART); LAS float* red = (LAS float*)lds;
      for (int u = blockIdx.x; u < NL * 2 * 64; u += gridDim.x) {
          const int lw = u & 3, kq = u >> 2, jn = tid & 127, kr = tid >> 7, k0 = kq * 32 + kr * 8;
          const float* pos = p.in[I_CPOS] + (size_t)lw * 2048; const float* w1 = p.in[I_CW1] + (size_t)lw * 2048 * 128;
          float a = 0.f;
#pragma unroll
          for (int i = 0; i < 8; ++i) a += pos[k0 + i] * w1[(size_t)(k0 + i) * 128 + jn];
          red[kr * 128 + jn] = a;
          __syncthreads();
          if (tid < 128) PART[(size_t)(lw * 64 + kq) * 128 + tid] = (red[tid] + red[128 + tid]) + (red[256 + tid] + red[384 + tid]);
          __syncthreads();
      } }
    { bf16_t* XB = (bf16_t*)(ws + O_XB0); const float* x = p.in[I_X];
      for (size_t i = gtid; i < (size_t)NT * D / 8; i += gstride) {
          const f32x4 a = *(const f32x4*)(x + i * 8), b = *(const f32x4*)(x + i * 8 + 4);
          u32x4 w; w.x = pk2(a[0], a[1]); w.y = pk2(a[2], a[3]); w.z = pk2(b[0], b[1]); w.w = pk2(b[2], b[3]);
          *(u32x4*)(XB + i * 8) = w;
          if (F8_P1) { u32x2 w8; w8.x = pk4_fp8(a[0] * XS8, a[1] * XS8, a[2] * XS8, a[3] * XS8); w8.y = pk4_fp8(b[0] * XS8, b[1] * XS8, b[2] * XS8, b[3] * XS8); *(u32x2*)(ws + O_XA8 + i * 8) = w8; }
      } }
    const int c = blockIdx.x, G = gridDim.x;
    for (int l = 0; l < NL; ++l) {
        for (int w = 0; w < 2; ++w) {
            { TrJob j{p.in[I_CW1] + (size_t)(l * 2 + w) * 2048 * 128, nullptr, 128, 128, (bf16_t*)(ws + O_W1) + (size_t)(l * 2 + w) * 128 * 2048, 2048, 0};
              const int nk = 2048 / 64;
              for (int u = c; u < nk; u += G) {
                  LAS float* T = (LAS float*)lds;
#pragma unroll
                  for (int q = 0; q < 2; ++q) { const int nn = tid & 63, n = q * 64 + nn;
#pragma unroll
                      for (int i = 0; i < 8; ++i) { const int kk = (tid >> 6) + 8 * i; T[(q * 64 + kk) * 65 + nn] = j.s0[(size_t)(u * 64 + kk) * 128 + n]; } }
                  __syncthreads();
#pragma unroll
                  for (int q = 0; q < 2; ++q) { const int nn = tid >> 3, kc = tid & 7; float v[8];
#pragma unroll
                      for (int i = 0; i < 8; ++i) v[i] = T[(q * 64 + kc * 8 + i) * 65 + nn];
                      u32x4 wv; wv.x = pk2(v[0], v[1]); wv.y = pk2(v[2], v[3]); wv.z = pk2(v[4], v[5]); wv.w = pk2(v[6], v[7]);
                      *(u32x4*)(j.dst + (size_t)(q * 64 + nn) * 2048 + u * 64 + kc * 8) = wv; }
                  __syncthreads();
              } }
            {
              bf16_t* dst = (bf16_t*)(ws + O_W2) + (size_t)(l * 2 + w) * 128 * 128; const float* src = p.in[I_CW2] + (size_t)(l * 2 + w) * 128 * 64;
              if (c == (l * 2 + w) % G) for (int i = tid; i < 128 * 128; i += NTHREADS) { const int n = i >> 7, k = i & 127; const float v = n < 64 ? src[k * 64 + n] : 0.f; dst[i] = (bf16_t)(pk2(v, 0.f) & 0xffffu); } }
        }
    }
    conv_stream(p, 0, 1024, lds, tid);
}

DI void proj_epilogue(const Params& p, int l, const f32x4 (&acc)[4][4], int rt, int ct, int wm, int wn, int fr, int fq) {
    char* R = p.ws + O_R;
    const float* bias = (const float*)(p.ws + O_BIASP) + (size_t)l * NP + ct * 128 + wn * 64;
    f32x4 bv[4];
#pragma unroll
    for (int n = 0; n < 4; ++n) bv[n] = *(const f32x4*)(bias + 16 * n + 4 * fq);
    int kind, head = 0, H = 1; bf16_t* dst = nullptr;
    if (ct < 4) { kind = 0; head = 2 * ct + wn; H = 8; }
    else if (ct < 10) { const int sec = ct - 4; head = wn; H = 2; kind = (sec == 2 || sec == 4) ? 2 : 1;
        const size_t off = sec == 0 ? R_KC : sec == 1 ? R_VC : sec == 2 ? R_KS : sec == 3 ? R_VS : sec == 4 ? R_KW : R_VW; dst = (bf16_t*)(R + off); }
    else if (ct < 14) { kind = 2; head = 2 * (ct - 10) + wn; H = 8; dst = (bf16_t*)(R + R_QB); }
    else if (ct < 18) { kind = 2; head = 2 * (ct - 14) + wn; H = 8; dst = (bf16_t*)(R + R_KB); }
    else if (ct < 22) { kind = 1; head = 2 * (ct - 18) + wn; H = 8; dst = (bf16_t*)(R + R_VB); }
    else if (ct < 30) { kind = 3; head = (ct - 22) * 128 + wn * 64; dst = (bf16_t*)(R + R_MA); }
    else if (ct < 38) { kind = 3; head = (ct - 30) * 128 + wn * 64; dst = (bf16_t*)(R + R_MB); }
    else { kind = 4; }
    const float* COS = (const float*)(p.ws + O_COS); const float* SIN = (const float*)(p.ws + O_SIN);
#pragma unroll
    for (int m = 0; m < 4; ++m) {
        const int t = rt * 256 + wm * 64 + 16 * m + fr, b = t >> 12, s = t & 4095;
        f32x4 v[4];
#pragma unroll
        for (int n = 0; n < 4; ++n) v[n] = acc[m][n] + bv[n];
        if (kind == 0 || kind == 2) {
            const f32x4 c0 = *(const f32x4*)(COS + s * 32 + 4 * fq), c1 = *(const f32x4*)(COS + s * 32 + 16 + 4 * fq);
            const f32x4 s0 = *(const f32x4*)(SIN + s * 32 + 4 * fq), s1 = *(const f32x4*)(SIN + s * 32 + 16 + 4 * fq);
            f32x4 r[4];
            r[0] = v[0] * c0 - v[2] * s0; r[2] = v[2] * c0 + v[0] * s0;
            r[1] = v[1] * c1 - v[3] * s1; r[3] = v[3] * c1 + v[1] * s1;
            const size_t o = ((size_t)((b * H + head) * SEQ + s)) * 64 + 4 * fq;
            if (kind == 0) {
                bf16_t* qa = (bf16_t*)(R + R_QA) + o; bf16_t* qar = (bf16_t*)(R + R_QAR) + o;
#pragma unroll
                for (int n = 0; n < 4; ++n) { st_bf16x4(qa + 16 * n, v[n]); st_bf16x4(qar + 16 * n, r[n]); }
            } else {
#pragma unroll
                for (int n = 0; n < 4; ++n) st_bf16x4(dst + o + 16 * n, r[n]);
            }
        } else if (kind == 1) {
            const size_t o = ((size_t)((b * H + head) * SEQ + s)) * 64 + 4 * fq;
#pragma unroll
            for (int n = 0; n < 4; ++n) st_bf16x4(dst + o + 16 * n, v[n]);
        } else if (kind == 3) {
            bf16_t* o = dst + (size_t)t * D + head + 4 * fq;
#pragma unroll
            for (int n = 0; n < 4; ++n) { f32x4 g; g[0] = sigmoidf_(v[n][0]); g[1] = sigmoidf_(v[n][1]); g[2] = sigmoidf_(v[n][2]); g[3] = sigmoidf_(v[n][3]); st_bf16x4(o + 16 * n, g); }
        } else {
            if (wn == 0) { float* ga = (float*)(R + R_GA) + (size_t)t * 24;
#pragma unroll
                for (int n = 0; n < 2; ++n)
#pragma unroll
                    for (int q = 0; q < 4; ++q) { const int cidx = 16 * n + 4 * fq + q; if (cidx < 24) ga[cidx] = sigmoidf_(v[n][q]); } }
        }
    }
}
DI void thread_rc(int tid, int& R0, int& C0) { stage_rc(tid * 16, R0, C0); }

DI void phase_proj(const Params& p, int l, LAS char* lds) {
    const int tid = opaque_tid(), lane = tid & 63, wid = tid >> 6, wm = wid >> 1, wn = wid & 1, fr = lane & 15, fq = lane >> 4;
    int R0, C0; thread_rc(tid, R0, C0);
    const bf16_t* A = (const bf16_t*)(p.ws + (l == 0 ? O_XB0 : O_XB1));
    const bf16_t* Bt = (const bf16_t*)(p.ws + O_WIN) + (size_t)l * NP * D;
    if (blockIdx.x < 2 && tid < 128) {
        const int lw = 2 * l + blockIdx.x; const float* PART = (const float*)(p.ws + O_C1PART) + (size_t)lw * 64 * 128;
        float a = p.in[I_CB1][lw * 128 + tid];
        for (int kq = 0; kq < 64; ++kq) a += PART[kq * 128 + tid];
        ((float*)(p.ws + O_C1))[lw * 128 + tid] = a;
    }
    for (int u = blockIdx.x; u < 128 * 39; u += gridDim.x) {
        const int rt = u / 39, ct = u % 39;
        const bf16_t* ap[4]; const bf16_t* bp[2];
#pragma unroll
        for (int i = 0; i < 4; ++i) ap[i] = A + (size_t)(rt * 256 + R0 + 64 * i) * D + C0;
#pragma unroll
        for (int i = 0; i < 2; ++i) bp[i] = Bt + (size_t)(ct * 128 + R0 + 64 * i) * D + C0;
        f32x4 acc[4][4]; zero_acc(acc);
        gemm_kloop<4, 2>(acc, ap, bp, D / 64, lds, tid);
        proj_epilogue(p, l, acc, rt, ct, wm, wn, fr, fq);
    }
}

DI float gelu_tanh(float x) { const float u = 0.7978845608028654f * (x + 0.044715f * x * x * x); const float e = __expf(2.0f * u); return 0.5f * x * (1.0f + (1.0f - 2.0f * frcp(e + 1.0f))); }
DI void phase_compress1(const Params& p, int l, LAS char* lds) {
    const int tid = opaque_tid(), lane = tid & 63, wid = tid >> 6, wm = wid >> 1, wn = wid & 1, fr = lane & 15, fq = lane >> 4;
    int R0, C0; thread_rc(tid, R0, C0);
    char* R = p.ws + O_R;
    for (int u = blockIdx.x; u < 32; u += gridDim.x) {
        const int w = u >> 4, bg = u & 15;
        const bf16_t* A = (const bf16_t*)(R + (w ? R_VC : R_KC)) + (size_t)bg * SEQ * 64;
        const bf16_t* Bt = (const bf16_t*)(p.ws + O_W1) + (size_t)(l * 2 + w) * 128 * 2048;
        const bf16_t* ap[4]; const bf16_t* bp[2];
#pragma unroll
        for (int i = 0; i < 4; ++i) ap[i] = A + (size_t)(R0 + 64 * i) * 1024 + C0;
#pragma unroll
        for (int i = 0; i < 2; ++i) bp[i] = Bt + (size_t)(R0 + 64 * i) * 2048 + C0;
        f32x4 acc[4][4]; zero_acc(acc);
        gemm_kloop<4, 2>(acc, ap, bp, 2048 / 64, lds, tid);
        const float* c1 = (const float*)(p.ws + O_C1) + (size_t)(l * 2 + w) * 128 + wn * 64;
        bf16_t* hid = (bf16_t*)(R + R_HID) + (size_t)(w * 16 + bg) * 256 * 128;
#pragma unroll
        for (int m = 0; m < 4; ++m) {
            const int row = wm * 64 + 16 * m + fr;
#pragma unroll
            for (int n = 0; n < 4; ++n) {
                const f32x4 cv = *(const f32x4*)(c1 + 16 * n + 4 * fq);
                f32x4 v = acc[m][n] + cv;
#pragma unroll
                for (int q = 0; q < 4; ++q) v[q] = (row < 255) ? gelu_tanh(v[q]) : 0.f;
                st_bf16x4(hid + (size_t)row * 128 + wn * 64 + 16 * n + 4 * fq, v);
            }
        }
    }
    {
        LAS float* red = (LAS float*)lds;
        const bf16_t* KB = (const bf16_t*)(R + R_KB); float* KM = (float*)(R + R_KMEAN);
        const int first = (blockIdx.x >= 32) ? (int)blockIdx.x - 32 : (int)blockIdx.x + (int)gridDim.x - 32;
        const int stride = gridDim.x;
        for (int u = first; u < 1024; u += stride) {
            if (u < 0) continue;
            const int bh = u >> 4, n = u & 15;
            const bf16_t* src = KB + ((size_t)bh * SEQ + n * 256) * 64;
            const int kr = tid >> 3, ch = tid & 7;
            float a[8];
#pragma unroll
            for (int j = 0; j < 8; ++j) a[j] = 0.f;
#pragma unroll
            for (int q = 0; q < 4; ++q) { const bf16x8 v = *(const bf16x8*)(src + (size_t)(kr + 64 * q) * 64 + ch * 8);
#pragma unroll
                for (int j = 0; j < 8; ++j) a[j] += bf2f((unsigned short)v[j]); }
#pragma unroll
            for (int j = 0; j < 8; ++j) red[kr * 65 + ch * 8 + j] = a[j];
            __syncthreads();
            if (tid < 64) { float s = 0.f; for (int k = 0; k < 64; ++k) s += red[k * 65 + tid]; KM[(size_t)u * 64 + tid] = s * (1.0f / 256.0f); }
            __syncthreads();
        }
    }
}
DI void phase_compress2(const Params& p, int l, LAS char* lds) {
    const int tid = opaque_tid(), lane = tid & 63, wid = tid >> 6, wm = wid >> 1, wn = wid & 1, fr = lane & 15, fq = lane >> 4;
    int R0, C0; thread_rc(tid, R0, C0);
    char* R = p.ws + O_R;
    for (int u = blockIdx.x; u < 32; u += gridDim.x) {
        const int w = u >> 4, bg = u & 15;
        const bf16_t* A = (const bf16_t*)(R + R_HID) + (size_t)(w * 16 + bg) * 256 * 128;
        const bf16_t* Bt = (const bf16_t*)(p.ws + O_W2) + (size_t)(l * 2 + w) * 128 * 128;
        const bf16_t* ap[4]; const bf16_t* bp[2];
#pragma unroll
        for (int i = 0; i < 4; ++i) ap[i] = A + (size_t)(R0 + 64 * i) * 128 + C0;
#pragma unroll
        for (int i = 0; i < 2; ++i) bp[i] = Bt + (size_t)(R0 + 64 * i) * 128 + C0;
        f32x4 acc[4][4]; zero_acc(acc);
        gemm_kloop<4, 2>(acc, ap, bp, 2, lds, tid);
        if (wn == 0) {
            bf16_t* dst = (bf16_t*)(R + (w ? R_VCC : R_KCC)) + (size_t)bg * 256 * 64;
#pragma unroll
            for (int m = 0; m < 4; ++m) { const int row = wm * 64 + 16 * m + fr;
#pragma unroll
                for (int n = 0; n < 4; ++n) st_bf16x4(dst + (size_t)row * 64 + 16 * n + 4 * fq, acc[m][n]); }
        }
    }
}

struct Flash { f32x16 o[2]; float m, l; };
DI void flash_init(Flash& f) {
#pragma unroll
    for (int i = 0; i < 16; ++i) { f.o[0][i] = 0.f; f.o[1][i] = 0.f; }
    f.m = 0.f; f.l = 0.f;
}
DI void kv_stage_write(LAS char* Kt, LAS char* Vt, u32x4 kr, u32x4 vr, int tid) {
    const int key = tid >> 3, ch = tid & 7;
    *(LAS u32x4*)(Kt + key * 144 + ch * 16) = kr;
    *(LAS u32x4*)(Vt + 1024 * (key >> 3) + 512 * (ch >> 2) + 64 * (key & 7) + 16 * (ch & 3)) = vr;
}
DI void qk_tile(f32x16& s0, f32x16& s1, const bf16x8 (&qf)[4], LAS const char* Kt, int r, int hh, float init = 0.f) {
#pragma unroll
    for (int i = 0; i < 16; ++i) { s0[i] = init; s1[i] = init; }
    LAS const char* base = Kt + r * 144 + hh * 16;
#pragma unroll
    for (int ks = 0; ks < 4; ++ks) {
        const bf16x8 a0 = *(LAS const bf16x8*)(base + ks * 32), a1 = *(LAS const bf16x8*)(base + 32 * 144 + ks * 32);
        s0 = mfma32(a0, qf[ks], s0); s1 = mfma32(a1, qf[ks], s1);
    }
}
DI bf16x8 pack8(const f32x16& s, int h8) {
    u32x4 w;
    w.x = pk2(s[h8 * 8 + 0], s[h8 * 8 + 1]); w.y = pk2(s[h8 * 8 + 2], s[h8 * 8 + 3]); w.z = pk2(s[h8 * 8 + 4], s[h8 * 8 + 5]); w.w = pk2(s[h8 * 8 + 6], s[h8 * 8 + 7]);
    return __builtin_bit_cast(bf16x8, w);
}
DI void pv_load(bf16x8 (&vf)[2][2][2], LAS const char* Vt, int lane) {
    const int i16 = lane & 15, q = i16 >> 2, pp = i16 & 3, G = lane >> 4;
    LAS const char* vb = Vt + 64 * (4 * (G >> 1) + q) + 32 * (G & 1) + 8 * pp;
#pragma unroll
    for (int kb = 0; kb < 2; ++kb)
#pragma unroll
        for (int sp = 0; sp < 2; ++sp)
#pragma unroll
            for (int db = 0; db < 2; ++db) {
                const s16x4 lo = __builtin_amdgcn_ds_read_tr16_b64_v4i16((LAS s16x4*)(vb + 4096 * kb + 2048 * sp + 512 * db));
                const s16x4 hi = __builtin_amdgcn_ds_read_tr16_b64_v4i16((LAS s16x4*)(vb + 4096 * kb + 2048 * sp + 512 * db + 1024));
                vf[kb][sp][db] = __builtin_shufflevector(lo, hi, 0, 1, 2, 3, 4, 5, 6, 7);
            }
}
DI void pv_mma(f32x16 (&o)[2], const f32x16& p0, const f32x16& p1, const bf16x8 (&vf)[2][2][2]) {
    bf16x8 pk[2][2];
    pk[0][0] = pack8(p0, 0); pk[0][1] = pack8(p0, 1); pk[1][0] = pack8(p1, 0); pk[1][1] = pack8(p1, 1);
#pragma unroll
    for (int kb = 0; kb < 2; ++kb)
#pragma unroll
        for (int sp = 0; sp < 2; ++sp)
#pragma unroll
            for (int db = 0; db < 2; ++db) o[db] = mfma32(vf[kb][sp][db], pk[kb][sp], o[db]);
}
DI void pv_tile(f32x16 (&o)[2], const f32x16& p0, const f32x16& p1, LAS const char* Vt, int lane) {
    bf16x8 vf[2][2][2]; pv_load(vf, Vt, lane); pv_mma(o, p0, p1, vf);
}
DI void mask_tile(f32x16& s0, f32x16& s1, int key0, bool rowok, int klo, int khi, int hh) {
    int lo2 = klo, span = khi - klo;
    if (!rowok || span < 0) { lo2 = 0x3fffffff; span = 0; }
    const int kb0 = key0 + 4 * hh - lo2;
#pragma unroll
    for (int i = 0; i < 16; ++i) {
        const int cr = (i & 3) + 8 * (i >> 2);
        s0[i] = ((unsigned)(kb0 + cr) <= (unsigned)span) ? s0[i] : -INFINITY;
        s1[i] = ((unsigned)(kb0 + 32 + cr) <= (unsigned)span) ? s1[i] : -INFINITY;
    }
}
DI void flash_step(Flash& f, const bf16x8 (&qf)[4], LAS const char* Kt, LAS const char* Vt, int key0, bool rowok, int klo, int khi, int lane) {
    const int r = lane & 31, hh = lane >> 5;
    const bool inside = klo <= key0 && khi >= key0 + 63;
    const bool fast = __all(inside || !rowok);
    const bool off = fast && !rowok;
    f32x16 s0, s1; qk_tile(s0, s1, qf, Kt, r, hh, off ? -INFINITY : -f.m);
    bf16x8 vf[2][2][2]; pv_load(vf, Vt, lane);
    __builtin_amdgcn_sched_barrier(0);
    if (!fast) mask_tile(s0, s1, key0, rowok, klo, khi, hh);
    float mx = -INFINITY;
#pragma unroll
    for (int i = 0; i < 16; ++i) mx = max3f(mx, s0[i], s1[i]);
    mx = fmaxf(mx, shx(mx, 32));
    const bool fresh = f.l == 0.f && mx > -INFINITY;
    const bool move = mx > 8.0f || (fresh && mx < -8.0f);
    if (__any(move)) {
        const float d = move ? mx : 0.f;
        const float alpha = (f.l == 0.f) ? 1.0f : fexp2(-d);
#pragma unroll
        for (int i = 0; i < 16; ++i) { s0[i] -= d; s1[i] -= d; f.o[0][i] *= alpha; f.o[1][i] *= alpha; }
        f.l *= alpha; f.m += d;
    }
    float rs = 0.f;
#pragma unroll
    for (int i = 0; i < 16; ++i) { s0[i] = fexp2(s0[i]); s1[i] = fexp2(s1[i]); rs += s0[i] + s1[i]; }
    rs += shx(rs, 32);
    f.l += rs;
    pv_mma(f.o, s0, s1, vf);
}
struct FlPre { u32x4 k, v; bool has; };
struct FlNext { const bf16_t* Kg; const bf16_t* Vg; int j; };
template <class Seq, class MaskFn>
DI void flash_loop(Flash& f, const bf16x8 (&qf)[4], const bf16_t* Kg, const bf16_t* Vg, Seq seq, MaskFn mf, LAS char* lds, int tid, FlPre* pre = nullptr, FlNext nx = FlNext{nullptr, nullptr, -1}) {
    const int lane = tid & 63;
#define FL_BAR() do { asm volatile("s_waitcnt lgkmcnt(0)" ::: "memory"); __builtin_amdgcn_s_barrier(); asm volatile("" ::: "memory"); } while (0)
    FL_BAR();
    int jc = seq.first();
    if (jc < 0) { if (pre) pre->has = false; return; }
    int j1 = seq.next(jc), j2 = j1 >= 0 ? seq.next(j1) : -1;
    u32x4 kA, vA, kB = {0u, 0u, 0u, 0u}, vB = {0u, 0u, 0u, 0u};
#define FL_LOAD(j, kr, vr) do { kr = *(const u32x4*)(Kg + (size_t)(j) * 4096 + tid * 8); vr = *(const u32x4*)(Vg + (size_t)(j) * 4096 + tid * 8); } while (0)
#define FL_STEP(j, bf) do { bool rowok; int klo, khi; mf((j), rowok, klo, khi); const int key0 = (j) * 64; \
        const bool need = rowok && khi >= key0 && klo <= key0 + 63; \
        if (__any(need)) flash_step(f, qf, lds + (bf) * 9216, lds + 18432 + (bf) * 8192, key0, rowok, klo, khi, lane); } while (0)
    if (pre && pre->has) { kA = pre->k; vA = pre->v; } else FL_LOAD(jc, kA, vA);
    kv_stage_write(lds, lds + 18432, kA, vA, tid);
    FL_BAR();
    if (j1 >= 0) FL_LOAD(j1, kA, vA);
    if (j2 >= 0) FL_LOAD(j2, kB, vB);
    if (pre) { pre->has = nx.j >= 0; if (nx.j >= 0) { pre->k = *(const u32x4*)(nx.Kg + (size_t)nx.j * 4096 + tid * 8); pre->v = *(const u32x4*)(nx.Vg + (size_t)nx.j * 4096 + tid * 8); } }
    for (;;) {
        FL_STEP(jc, 0);
        if (j1 < 0) break;
        kv_stage_write(lds + 9216, lds + 18432 + 8192, kA, vA, tid);
        const int j3 = j2 >= 0 ? seq.next(j2) : -1;
        if (j3 >= 0) FL_LOAD(j3, kA, vA);
        FL_BAR();
        FL_STEP(j1, 1);
        if (j2 < 0) break;
        kv_stage_write(lds, lds + 18432, kB, vB, tid);
        const int j4 = j3 >= 0 ? seq.next(j3) : -1;
        if (j4 >= 0) FL_LOAD(j4, kB, vB);
        FL_BAR();
        jc = j2; j1 = j3; j2 = j4;
    }
    FL_BAR();
#undef FL_BAR
#undef FL_LOAD
#undef FL_STEP
}
struct SeqRange { int a, b; DI int first() const { return a <= b ? a : -1; } DI int next(int j) const { return j < b ? j + 1 : -1; } };
struct SeqMask { unsigned long long m; DI int first() const { return m ? (int)__builtin_ctzll(m) : -1; }
    DI int next(int j) const { const unsigned long long r = (j >= 63) ? 0ull : (m >> (j + 1)); return r ? j + 1 + (int)__builtin_ctzll(r) : -1; } };

DI void load_qf(bf16x8 (&qf)[4], const bf16_t* qrow, int hh) {
#pragma unroll
    for (int ks = 0; ks < 4; ++ks) qf[ks] = *(const bf16x8*)(qrow + 16 * ks + 8 * hh);
}
DI unsigned long long shx64(unsigned long long v, int m) { const unsigned lo = __shfl_xor((unsigned)v, m), hi = __shfl_xor((unsigned)(v >> 32), m); return ((unsigned long long)hi << 32) | lo; }

DI void lane_o_store(bf16_t* row, const f32x16 (&o)[2], float sc, int hh) {
#pragma unroll
    for (int db = 0; db < 2; ++db)
#pragma unroll
        for (int ap = 0; ap < 2; ++ap) {
            u32x4 w; w.x = pk2(o[db][8 * ap] * sc, o[db][8 * ap + 1] * sc); w.y = pk2(o[db][8 * ap + 2] * sc, o[db][8 * ap + 3] * sc);
            w.z = pk2(o[db][8 * ap + 4] * sc, o[db][8 * ap + 5] * sc); w.w = pk2(o[db][8 * ap + 6] * sc, o[db][8 * ap + 7] * sc);
            *(u32x4*)(row + 32 * hh + 16 * db + 8 * ap) = w;
        }
}
DI void lane_o_load(bf16x8 (&raw)[2][2], const bf16_t* row, int hh, bool on) {
#pragma unroll
    for (int db = 0; db < 2; ++db)
#pragma unroll
        for (int ap = 0; ap < 2; ++ap) raw[db][ap] = on ? *(const bf16x8*)(row + 32 * hh + 16 * db + 8 * ap) : (bf16x8){0, 0, 0, 0, 0, 0, 0, 0};
}
constexpr int WIN_SPLIT = 32;
DI void nsa_win_unit(const Params& p, int b, int g, int qb, LAS char* lds, int tid) {
    char* R = p.ws + O_R;
    const int lane = tid & 63, w = tid >> 6, r = lane & 31, hh = lane >> 5;
    const int qi = 8 * w + (r >> 2), head = 4 * g + (r & 3), qpos = 64 * qb + qi, t = b * SEQ + qpos;
    const size_t qoff = ((size_t)((b * 8 + head) * SEQ + qpos)) * 64;
    const float g2 = ((const float*)(R + R_GA))[(size_t)t * 24 + head * 3 + 2];
    bf16_t* oa = (bf16_t*)(R + R_OA) + (size_t)t * 512 + head * 64;
    bf16x8 qf[4]; load_qf(qf, (const bf16_t*)(R + R_QAR) + qoff, hh);
    Flash f; flash_init(f);
    const bf16_t* Kg = (const bf16_t*)(R + R_KW) + (size_t)(b * 2 + g) * SEQ * 64;
    const bf16_t* Vg = (const bf16_t*)(R + R_VW) + (size_t)(b * 2 + g) * SEQ * 64;
    const int qp = qpos;
    flash_loop(f, qf, Kg, Vg, SeqRange{qb >= 8 ? qb - 8 : 0, qb}, [qp](int, bool& ok, int& klo, int& khi) { ok = true; klo = qp - 511; khi = qp; }, lds, tid);
    lane_o_store(oa, f.o, (f.l > 0.f ? 1.0f / f.l : 0.f) * g2, hh);
}
DI void nsa_unit(const Params& p, int b, int g, int qb, LAS char* lds, int tid_) {
    char* R = p.ws + O_R; (void)tid_;
    const int tid = opaque_tid();
    const int lane = tid & 63, w = tid >> 6, r = lane & 31, hh = lane >> 5;
    const int qi = 8 * w + (r >> 2), head = 4 * g + (r & 3), qpos = 64 * qb + qi, t = b * SEQ + qpos;
    const size_t qoff = ((size_t)((b * 8 + head) * SEQ + qpos)) * 64;
    const float* ga = (const float*)(R + R_GA) + (size_t)t * 24 + head * 3;
    const float g0 = ga[0], g1 = ga[1], g2 = ga[2];
    bf16_t* oa = (bf16_t*)(R + R_OA) + (size_t)t * 512 + head * 64;
    unsigned char* oa8 = F8_P5 ? (unsigned char*)(p.ws + O_OA8) + (size_t)t * 512 + head * 64 : nullptr;
    f32x16 tot[2];
#pragma unroll
    for (int i = 0; i < 16; ++i) { tot[0][i] = 0.f; tot[1][i] = 0.f; }
    unsigned long long selmask = 0ull;
    {
        LAS char* Kc = lds; LAS char* Vc = lds + 36864;
        const int ntile = ((4 * qb + 2) >> 6) + 1;
        const bf16_t* kcg = (const bf16_t*)(R + R_KCC) + (size_t)(b * 2 + g) * 256 * 64;
        const bf16_t* vcg = (const bf16_t*)(R + R_VCC) + (size_t)(b * 2 + g) * 256 * 64;
        __syncthreads();
        for (int tl = 0; tl < ntile; ++tl) {
            const u32x4 kr = *(const u32x4*)(kcg + (size_t)tl * 4096 + tid * 8), vr = *(const u32x4*)(vcg + (size_t)tl * 4096 + tid * 8);
            kv_stage_write(Kc + tl * 9216, Vc + tl * 8192, kr, vr, tid);
        }
        bf16x8 qf[4]; load_qf(qf, (const bf16_t*)(R + R_QA) + qoff, hh);
        __syncthreads();
        const int nvis = (qpos - 31) >> 4;
        float m = NEGF, lsum = 0.f;
#pragma unroll 1
        for (int tl = 0; tl < ntile; ++tl) {
            f32x16 s0, s1; qk_tile(s0, s1, qf, Kc + tl * 9216, r, hh);
            mask_tile(s0, s1, tl * 64, true, 0, nvis, hh);
            float mx = -INFINITY;
#pragma unroll
            for (int i = 0; i < 16; ++i) mx = fmaxf(mx, fmaxf(s0[i], s1[i]));
            mx = fmaxf(mx, shx(mx, 32));
            const float mn = fmaxf(m, mx), mc = mn;
            float rs = 0.f;
#pragma unroll
            for (int i = 0; i < 16; ++i) rs += fexp2(s0[i] - mc) + fexp2(s1[i] - mc);
            rs += shx(rs, 32);
            lsum = lsum * fexp2(m - mn) + rs; m = mn;
        }
        const float inv = lsum > 0.f ? 1.0f / lsum : 0.f, mc = m;
        f32x16 o[2];
#pragma unroll
        for (int i = 0; i < 16; ++i) { o[0][i] = 0.f; o[1][i] = 0.f; }
        LAS float* IMPw = (LAS float*)(lds + 69632) + w * 512 + (r >> 2) * 64;
        float carry = 0.f;
#pragma unroll 1
        for (int tl = 0; tl < 4; ++tl) {
            float iv[8];
#pragma unroll
            for (int k = 0; k < 8; ++k) iv[k] = 0.f;
            iv[0] = carry; carry = 0.f;
            if (tl < ntile) {
                f32x16 s0, s1; qk_tile(s0, s1, qf, Kc + tl * 9216, r, hh);
                mask_tile(s0, s1, tl * 64, true, 0, nvis, hh);
#pragma unroll
                for (int i = 0; i < 16; ++i) { s0[i] = fexp2(s0[i] - mc) * inv; s1[i] = fexp2(s1[i] - mc) * inv; }
#pragma unroll
                for (int kb = 0; kb < 2; ++kb)
#pragma unroll
                    for (int a = 0; a < 4; ++a) {
                        const int k = kb * 4 + a;
                        const float p0 = kb ? s1[4 * a] : s0[4 * a], p1 = kb ? s1[4 * a + 1] : s0[4 * a + 1], p2 = kb ? s1[4 * a + 2] : s0[4 * a + 2], p3 = kb ? s1[4 * a + 3] : s0[4 * a + 3];
                        iv[k] += 2.0f * (p0 + p1 + p2) + p3;
                        const float rcv = shx(p3, 32);
                        iv[k] += hh ? rcv : 0.f;
                        if (k + 1 < 8) iv[k + 1] += hh ? 0.f : rcv; else carry = hh ? 0.f : rcv;
                    }
                pv_tile(o, s0, s1, Vc + tl * 8192, lane);
            }
#pragma unroll
            for (int k = 0; k < 8; ++k) { iv[k] += shx(iv[k], 1); iv[k] += shx(iv[k], 2); }
            if ((r & 3) == 0) {
#pragma unroll
                for (int k = 0; k < 8; ++k) IMPw[2 * (tl * 8 + k) + hh] = iv[k];
            }
        }
#pragma unroll
        for (int i = 0; i < 16; ++i) { tot[0][i] += o[0][i] * g0; tot[1][i] += o[1][i] * g0; }
        asm volatile("s_waitcnt lgkmcnt(0)" ::: "memory");
        const int sub = (r & 3) * 2 + hh, jb = 8 * sub;
        float v[8]; int rank[8];
#pragma unroll
        for (int c = 0; c < 8; ++c) { const int j = jb + c; const float x = IMPw[j];
            v[c] = (j == 0 || j == qb || j == qb - 1) ? BIGF : (j <= qb ? x : NEGF); rank[c] = 0; }
        if (qb >= 16) for (int j2 = 0; j2 <= qb; ++j2) {
            const float x = IMPw[j2];
            const float x2 = (j2 == 0 || j2 == qb || j2 == qb - 1) ? BIGF : (j2 <= qb ? x : NEGF);
#pragma unroll
            for (int c = 0; c < 8; ++c) rank[c] += ((x2 > v[c]) || (x2 == v[c] && j2 < jb + c)) ? 1 : 0;
        }
        unsigned bits = 0;
#pragma unroll
        for (int c = 0; c < 8; ++c) bits |= (rank[c] < 16 && (jb + c) <= qb) ? (1u << c) : 0u;
        const unsigned part = bits << (8 * (sub & 3));
        unsigned long long mk = (sub < 4) ? (unsigned long long)part : ((unsigned long long)part << 32);
        mk |= shx64(mk, 1); mk |= shx64(mk, 2); mk |= shx64(mk, 32);
        selmask = mk;
    }
    unsigned long long uni = selmask;
    uni |= shx64(uni, 4); uni |= shx64(uni, 8); uni |= shx64(uni, 16);
    LAS unsigned long long* UNI = (LAS unsigned long long*)(lds + 69632 + 16384);
    __syncthreads();
    if (lane == 0) UNI[w] = uni;
    __syncthreads();
    uni = 0ull;
#pragma unroll
    for (int i = 0; i < 8; ++i) uni |= UNI[i];
    { const unsigned ulo = __builtin_amdgcn_readfirstlane((unsigned)uni), uhi = __builtin_amdgcn_readfirstlane((unsigned)(uni >> 32)); uni = ((unsigned long long)uhi << 32) | ulo; }
    bf16x8 qf[4]; load_qf(qf, (const bf16_t*)(R + R_QAR) + qoff, hh);
    bf16x8 oldw[2][2];
    lane_o_load(oldw, oa, hh, qb >= WIN_SPLIT);
    {
        Flash f; flash_init(f);
        const bf16_t* Kg = (const bf16_t*)(R + R_KS) + (size_t)(b * 2 + g) * SEQ * 64;
        const bf16_t* Vg = (const bf16_t*)(R + R_VS) + (size_t)(b * 2 + g) * SEQ * 64;
        const unsigned long long sm = selmask; const int qp = qpos;
        flash_loop(f, qf, Kg, Vg, SeqMask{uni}, [sm, qp](int j, bool& ok, int& klo, int& khi) { ok = (sm >> j) & 1ull; klo = 0; khi = qp; }, lds, tid);
        const float sc = (f.l > 0.f ? 1.0f / f.l : 0.f) * g1;
#pragma unroll
        for (int i = 0; i < 16; ++i) { tot[0][i] += f.o[0][i] * sc; tot[1][i] += f.o[1][i] * sc; }
    }
    if (qb < WIN_SPLIT) {
        Flash f; flash_init(f);
        const bf16_t* Kg = (const bf16_t*)(R + R_KW) + (size_t)(b * 2 + g) * SEQ * 64;
        const bf16_t* Vg = (const bf16_t*)(R + R_VW) + (size_t)(b * 2 + g) * SEQ * 64;
        const int qp = qpos;
        flash_loop(f, qf, Kg, Vg, SeqRange{qb >= 8 ? qb - 8 : 0, qb}, [qp](int, bool& ok, int& klo, int& khi) { ok = true; klo = qp - 511; khi = qp; }, lds, tid);
        const float sc = (f.l > 0.f ? 1.0f / f.l : 0.f) * g2;
#pragma unroll
        for (int i = 0; i < 16; ++i) { tot[0][i] += f.o[0][i] * sc; tot[1][i] += f.o[1][i] * sc; }
    }
#pragma unroll
    for (int db = 0; db < 2; ++db)
#pragma unroll
        for (int a = 0; a < 4; ++a) {
            f32x4 v4;
#pragma unroll
            for (int j = 0; j < 4; ++j) v4[j] = tot[db][4 * a + j] + bf2f((unsigned short)oldw[db][a >> 1][4 * (a & 1) + j]);
            if (F8_P5) *(unsigned*)(oa8 + 32 * db + 8 * a + 4 * hh) = pk4_fp8(v4[0] * OS8, v4[1] * OS8, v4[2] * OS8, v4[3] * OS8);
            else st_bf16x4(oa + 32 * db + 8 * a + 4 * hh, v4);
        }
}

DI void moba_unit(const Params& p, int b, int h, int qblk, LAS char* lds, int tid) {
    char* R = p.ws + O_R;
    const int lane = tid & 63, w = tid >> 6, r = lane & 31, hh = lane >> 5;
    const int qpos = 256 * qblk + 32 * w + r, t = b * SEQ + qpos;
    const size_t slab = (size_t)(b * 8 + h) * SEQ * 64;
    bf16x8 qf[4]; load_qf(qf, (const bf16_t*)(R + R_QB) + slab + (size_t)qpos * 64, hh);
    LAS float* KM = (LAS float*)(lds + 36864);
    __syncthreads();
    { const float* km = (const float*)(R + R_KMEAN) + (size_t)(b * 8 + h) * 1024; KM[tid] = km[tid]; KM[tid + 512] = km[tid + 512]; }
    __syncthreads();
    float dot[16];
#pragma unroll
    for (int n = 0; n < 16; ++n) {
        float a = 0.f;
        if (n < qblk) {
#pragma unroll
            for (int ks = 0; ks < 4; ++ks) {
                const f32x4 k0 = *(LAS const f32x4*)(KM + n * 64 + 16 * ks + 8 * hh), k1 = *(LAS const f32x4*)(KM + n * 64 + 16 * ks + 8 * hh + 4);
#pragma unroll
                for (int j = 0; j < 4; ++j) { a += bf2f((unsigned short)qf[ks][j]) * k0[j]; a += bf2f((unsigned short)qf[ks][4 + j]) * k1[j]; }
            }
            a += shx(a, 32);
        }
        dot[n] = a;
    }
    unsigned bm = 0;
#pragma unroll
    for (int it = 0; it < 3; ++it) {
        float best = -INFINITY; int bi = -1;
#pragma unroll
        for (int n = 0; n < 16; ++n) { const bool cand = (n < qblk) && !((bm >> n) & 1u); if (cand && dot[n] > best) { best = dot[n]; bi = n; } }
        if (bi >= 0) bm |= 1u << bi;
    }
    Flash f; flash_init(f);
    const bf16_t* Kg = (const bf16_t*)(R + R_KB) + slab; const bf16_t* Vg = (const bf16_t*)(R + R_VB) + slab;
    const int qp = qpos, qk4 = 4 * qblk;
    flash_loop(f, qf, Kg, Vg, SeqRange{0, 4 * qblk + 3}, [bm, qp, qk4](int j, bool& ok, int& klo, int& khi) {
        if (j < qk4) { ok = (bm >> (j >> 2)) & 1u; klo = 0; khi = 0x3ffffff; } else { ok = true; klo = 0; khi = qp; } }, lds, tid);
    const float sc = f.l > 0.f ? 1.0f / f.l : 0.f;
    bf16_t* ob = (bf16_t*)(R + R_OB) + (size_t)t * 512 + h * 64;
#pragma unroll
    for (int db = 0; db < 2; ++db)
#pragma unroll
        for (int a = 0; a < 4; ++a) { f32x4 v4 = {f.o[db][4 * a] * sc, f.o[db][4 * a + 1] * sc, f.o[db][4 * a + 2] * sc, f.o[db][4 * a + 3] * sc}; st_bf16x4(ob + 32 * db + 8 * a + 4 * hh, v4); }
}

static_assert(F8_M1 && F8_M2, "both layers' expert weights share the bf16-sized regions: fp8 only");
#ifndef MOBA_SPARSE
#define MOBA_SPARSE 1
#endif
static_assert(MOBA_SPARSE || !F8_P5, "the dense MoBA unit only writes the bf16 output");
constexpr size_t MO_LIST = O_H;
constexpr size_t MO_PO = MO_LIST + (size_t)1024 * 4096 * 4;
constexpr size_t MO_PML = MO_PO + (size_t)NT * 8 * 3 * 64 * 2;
static_assert(MO_PML + (size_t)NT * 8 * 3 * 2 * 4 <= O_R, "MoBA scratch does not fit in the H region");
DI unsigned* moba_cnt(const Params& p, int l) { return (unsigned*)(p.ws + O_MISC + 2048 + (size_t)l * 4096); }
DI unsigned moba_topk(const bf16x8 (&qf)[4], LAS const float* KM, int qblk, int hh) {
    float dot[16];
#pragma unroll
    for (int n = 0; n < 16; ++n) {
        float a = 0.f;
        if (n < qblk) {
#pragma unroll
            for (int ks = 0; ks < 4; ++ks) {
                const f32x4 k0 = *(LAS const f32x4*)(KM + n * 64 + 16 * ks + 8 * hh), k1 = *(LAS const f32x4*)(KM + n * 64 + 16 * ks + 8 * hh + 4);
#pragma unroll
                for (int j = 0; j < 4; ++j) { a += bf2f((unsigned short)qf[ks][j]) * k0[j]; a += bf2f((unsigned short)qf[ks][4 + j]) * k1[j]; }
            }
            a += shx(a, 32);
        }
        dot[n] = a;
    }
    unsigned bm = 0;
#pragma unroll
    for (int it = 0; it < 3; ++it) {
        float best = -INFINITY; int bi = -1;
#pragma unroll
        for (int n = 0; n < 16; ++n) { const bool cand = (n < qblk) && !((bm >> n) & 1u); if (cand && dot[n] > best) { best = dot[n]; bi = n; } }
        if (bi >= 0) bm |= 1u << bi;
    }
    return bm;
}
DI void moba_gate_unit(const Params& p, int l, int bh, int qblk, LAS char* lds, int tid) {
    char* R = p.ws + O_R;
    const int lane = tid & 63, w = tid >> 6, r = lane & 31, hh = lane >> 5;
    const int qpos = 256 * qblk + 32 * w + r;
    LAS float* KM = (LAS float*)(lds + 36864);
    LAS unsigned* wc = (LAS unsigned*)(lds + 36864 + 4096);
    LAS unsigned* lbase = wc + 128;
    __syncthreads();
    { const float* km = (const float*)(R + R_KMEAN) + (size_t)bh * 1024; KM[tid] = km[tid]; KM[tid + 512] = km[tid + 512]; }
    __syncthreads();
    bf16x8 qf[4]; load_qf(qf, (const bf16_t*)(R + R_QB) + ((size_t)bh * SEQ + qpos) * 64, hh);
    const unsigned bm = moba_topk(qf, KM, qblk, hh);
#pragma unroll
    for (int n = 0; n < 16; ++n) if (n < qblk) {
        const unsigned long long m64 = __ballot(((bm >> n) & 1u) && hh == 0);
        if (lane == 0) wc[n * 8 + w] = (unsigned)__builtin_popcountll(m64);
    }
    __syncthreads();
    if (tid < qblk) {
        unsigned tot = 0;
#pragma unroll
        for (int ww = 0; ww < 8; ++ww) { const unsigned cc = wc[tid * 8 + ww]; wc[tid * 8 + ww] = tot; tot += cc; }
        lbase[tid] = tot ? atomicAdd(moba_cnt(p, l) + bh * 16 + tid, tot) : 0u;
    }
    __syncthreads();
    unsigned* LIST = (unsigned*)(p.ws + MO_LIST);
#pragma unroll
    for (int n = 0; n < 16; ++n) if (n < qblk) {
        const bool sel = ((bm >> n) & 1u) && hh == 0;
        const unsigned long long m64 = __ballot(sel);
        if (sel) {
            const unsigned pos = lbase[n] + wc[n * 8 + w] + (unsigned)__builtin_popcountll(m64 & ((1ull << lane) - 1ull));
            LIST[(size_t)(bh * 16 + n) * 4096 + pos] = ((unsigned)qpos << 2) | (unsigned)__builtin_popcount(bm & ((1u << n) - 1u));
        }
    }
}
DI void moba_items(const Params& p, int l, LAS char* lds, int tid) {
    char* R = p.ws + O_R;
    const int lane = tid & 63, w = tid >> 6, r = lane & 31, hh = lane >> 5;
    LAS unsigned* pre = (LAS unsigned*)(lds + 40960);
    LAS unsigned* cnts = pre + 1024;
    const unsigned* MC = moba_cnt(p, l);
    __syncthreads();
    for (int i = tid; i < 1024; i += NTHREADS) { const unsigned cc = MC[i]; cnts[i] = cc; pre[i] = (cc + 255u) >> 8; }
    __syncthreads();
    if (tid < 64) {
        unsigned run = 0;
        for (int k = 0; k < 16; ++k) { run += pre[tid * 16 + k]; pre[tid * 16 + k] = run; }
        unsigned inc = run;
#pragma unroll
        for (int d = 1; d < 64; d <<= 1) { const unsigned o = __shfl_up(inc, d); if (lane >= d) inc += o; }
        const unsigned excl = inc - run;
        for (int k = 0; k < 16; ++k) pre[tid * 16 + k] += excl;
    }
    __syncthreads();
    const int T = (int)pre[1023];
    const unsigned* LIST = (const unsigned*)(p.ws + MO_LIST);
    bf16_t* PO = (bf16_t*)(p.ws + MO_PO); float* PML = (float*)(p.ws + MO_PML);
    for (int it = blockIdx.x; it < T; it += gridDim.x) {
        int lo = 0, hi = 1023;
        while (lo < hi) { const int mid = (lo + hi) >> 1; if (pre[mid] > (unsigned)it) hi = mid; else lo = mid + 1; }
        const int idx = lo, chunk = it - (idx ? (int)pre[idx - 1] : 0), bh = idx >> 4, n = idx & 15;
        const int e = 256 * chunk + 32 * w + r; const bool valid = e < (int)cnts[idx];
        const unsigned entry = valid ? LIST[(size_t)idx * 4096 + e] : 0u;
        const int s = (int)(entry >> 2), slot = (int)(entry & 3u);
        const size_t slab = (size_t)bh * SEQ * 64;
        bf16x8 qf[4]; load_qf(qf, (const bf16_t*)(R + R_QB) + slab + (size_t)s * 64, hh);
        Flash f; flash_init(f);
        const int vi = valid ? 1 : 0;
        flash_loop(f, qf, (const bf16_t*)(R + R_KB) + slab, (const bf16_t*)(R + R_VB) + slab, SeqRange{4 * n, 4 * n + 3},
                   [vi](int, bool& ok, int& klo, int& khi) { ok = vi != 0; klo = 0; khi = 0x3ffffff; }, lds, tid);
        if (valid) {
            const float inv = f.l > 0.f ? 1.0f / f.l : 0.f;
            const size_t pi = ((size_t)bh * SEQ + s) * 3 + slot;
            lane_o_store(PO + pi * 64, f.o, inv, hh);
            if (hh == 0) { f32x2 ml = {f.m, f.l}; *(f32x2*)(PML + pi * 2) = ml; }
        }
    }
}
DI void moba_own_unit(const Params& p, int b, int h, int qblk, LAS char* lds, int tid, int var, const bf16x8 (&qf)[4], FlPre* pre, FlNext nx) {
    char* R = p.ws + O_R;
    const int lane = tid & 63, w = tid >> 6, r = lane & 31, hh = lane >> 5;
    const int qpos = 256 * qblk + 32 * w + r, t = b * SEQ + qpos;
    const size_t slab = (size_t)(b * 8 + h) * SEQ * 64;
    Flash f; flash_init(f);
    const int qp = qpos;
    const int np = qblk < 3 ? qblk : 3;
    const bf16_t* PO = (const bf16_t*)(p.ws + MO_PO); const float* PML = (const float*)(p.ws + MO_PML);
    const size_t pi = ((size_t)(b * 8 + h) * SEQ + qpos) * 3;
    f32x2 mlr[3]; bf16x8 por[3][2][2];
#pragma unroll
    for (int k = 0; k < 3; ++k) {
        mlr[k] = (k < np) ? *(const f32x2*)(PML + (pi + k) * 2) : (f32x2){0.f, 0.f};
        lane_o_load(por[k], PO + (pi + k) * 64, hh, k < np);
    }
    if (var != 4) flash_loop(f, qf, (const bf16_t*)(R + R_KB) + slab, (const bf16_t*)(R + R_VB) + slab, SeqRange{(var == 2 && qblk > 0) ? 4 * qblk - 4 : ((var == 3 && qblk > 1) ? 4 * qblk - 8 : 4 * qblk), 4 * qblk + 3},
               [qp](int, bool& ok, int& klo, int& khi) { ok = true; klo = 0; khi = qp; }, lds, tid, pre, nx);
    float mk[3], lk[3], M = f.m;
#pragma unroll
    for (int k = 0; k < 3; ++k) { mk[k] = 0.f; lk[k] = 0.f; if (k < np) { mk[k] = mlr[k][0]; lk[k] = mlr[k][1]; M = fmaxf(M, mk[k]); } }
    const float w0 = fexp2(f.m - M);
    float den = f.l * w0;
#pragma unroll
    for (int i = 0; i < 16; ++i) { f.o[0][i] *= w0; f.o[1][i] *= w0; }
#pragma unroll
    for (int k = 0; k < 3; ++k) if (k < np) {
        const float wk = lk[k] * fexp2(mk[k] - M); den += wk;
#pragma unroll
        for (int db = 0; db < 2; ++db)
#pragma unroll
            for (int i = 0; i < 16; ++i) f.o[db][i] += wk * bf2f((unsigned short)por[k][db][i >> 3][i & 7]);
    }
    const float sc = den > 0.f ? 1.0f / den : 0.f;
    bf16_t* ob = (bf16_t*)(R + R_OB) + (size_t)t * 512 + h * 64;
#pragma unroll
    for (int db = 0; db < 2; ++db)
#pragma unroll
        for (int a = 0; a < 4; ++a) { f32x4 v4 = {f.o[db][4 * a] * sc, f.o[db][4 * a + 1] * sc, f.o[db][4 * a + 2] * sc, f.o[db][4 * a + 3] * sc};
            if (F8_P5) *(unsigned*)((unsigned char*)(p.ws + O_OB8) + (size_t)t * 512 + h * 64 + 32 * db + 8 * a + 4 * hh) = pk4_fp8(v4[0] * OS8, v4[1] * OS8, v4[2] * OS8, v4[3] * OS8);
            else st_bf16x4(ob + 32 * db + 8 * a + 4 * hh, v4); }
}
DI void phase_moba_own(const Params& p, LAS char* lds, int var) {
    char* R = p.ws + O_R;
    const int tid = opaque_tid(), lane = tid & 63, w = tid >> 6, r = lane & 31, hh = lane >> 5, G = gridDim.x;
    FlPre pre; pre.has = false; pre.k = (u32x4){0u, 0u, 0u, 0u}; pre.v = pre.k;
    bf16x8 qn[4];
    int u = blockIdx.x;
    if (u < 1024) load_qf(qn, (const bf16_t*)(R + R_QB) + ((size_t)(u & 63) * SEQ + 256 * (u >> 6) + 32 * w + r) * 64, hh);
    for (; u < 1024; u += G) {
        bf16x8 qf[4];
#pragma unroll
        for (int i = 0; i < 4; ++i) qf[i] = qn[i];
        const int un = u + G; FlNext nx{nullptr, nullptr, -1};
        if (un < 1024) {
            const size_t slabn = (size_t)(un & 63) * SEQ * 64;
            if (var == 0) nx = FlNext{(const bf16_t*)(R + R_KB) + slabn, (const bf16_t*)(R + R_VB) + slabn, 4 * (un >> 6)};
            load_qf(qn, (const bf16_t*)(R + R_QB) + slabn + (size_t)(256 * (un >> 6) + 32 * w + r) * 64, hh);
        }
        moba_own_unit(p, (u & 63) >> 3, u & 7, u >> 6, lds, tid, var, qf, &pre, nx);
    }
}
DI void phase_attention(const Params& p, int l, LAS char* lds, int which = 3) {
    const int tid = opaque_tid(), G = gridDim.x, c = blockIdx.x;
    if (which & 1) for (int rnd = 0; rnd * G < 1024; ++rnd) {
        const int i = rnd * G + ((rnd & 1) ? G - 1 - c : c);
        if (i < 1024) { const int qb = 63 - (i >> 4), bg = i & 15; nsa_unit(p, bg >> 1, bg & 1, qb, lds, tid); }
    }
#if MOBA_SPARSE
    if (which & 2) moba_items(p, l, lds, tid);
#else
    if (which & 2) for (int rnd = 0; rnd * G < 1024; ++rnd) {
        const int i = rnd * G + ((rnd & 1) ? G - 1 - c : c);
        if (i < 1024) { const int qblk = 15 - (i >> 6), bh = i & 63; moba_unit(p, bh >> 3, bh & 7, qblk, lds, tid); }
    }
#endif
}

DI void phase_projab(const Params& p, int l, LAS char* lds) {
    const int tid = opaque_tid(), lane = tid & 63, wid = tid >> 6, wm = wid >> 1, wn = wid & 1, fr = lane & 15, fq = lane >> 4;
    int R0, C0; thread_rc(tid, R0, C0);
    char* R = p.ws + O_R;
    const bf16_t* OA = (const bf16_t*)(R + R_OA); const bf16_t* OB = (const bf16_t*)(R + R_OB);
    const bf16_t* WA = (const bf16_t*)(p.ws + O_WPA) + (size_t)l * D * 512; const bf16_t* WB = (const bf16_t*)(p.ws + O_WPB) + (size_t)l * D * 512;
    const bf16_t* MA = (const bf16_t*)(R + R_MA); const bf16_t* MB = (const bf16_t*)(R + R_MB); bf16_t* MG = (bf16_t*)(R + R_MERGED);
    for (int u = blockIdx.x; u < 128 * 8; u += gridDim.x) {
        const int rt = u >> 3, ct = u & 7;
        const bf16_t* ap[4]; const bf16_t* bp[2];
        f32x4 acc[4][4], acc2[4][4]; zero_acc(acc); zero_acc(acc2);
#pragma unroll
        for (int i = 0; i < 4; ++i) ap[i] = OA + (size_t)(rt * 256 + R0 + 64 * i) * 512 + C0;
#pragma unroll
        for (int i = 0; i < 2; ++i) bp[i] = WA + (size_t)(ct * 128 + R0 + 64 * i) * 512 + C0;
        gemm_kloop<4, 2>(acc, ap, bp, 8, lds, tid);
#pragma unroll
        for (int i = 0; i < 4; ++i) ap[i] = OB + (size_t)(rt * 256 + R0 + 64 * i) * 512 + C0;
#pragma unroll
        for (int i = 0; i < 2; ++i) bp[i] = WB + (size_t)(ct * 128 + R0 + 64 * i) * 512 + C0;
        gemm_kloop<4, 2>(acc2, ap, bp, 8, lds, tid);
#pragma unroll
        for (int m = 0; m < 4; ++m) {
            const size_t o = (size_t)(rt * 256 + wm * 64 + 16 * m + fr) * D + ct * 128 + wn * 64 + 4 * fq;
#pragma unroll
            for (int n = 0; n < 4; ++n) {
                const s16x4 ma = *(const s16x4*)(MA + o + 16 * n), mb = *(const s16x4*)(MB + o + 16 * n);
                f32x4 v;
#pragma unroll
                for (int q = 0; q < 4; ++q) v[q] = bf2f((unsigned short)ma[q]) * acc[m][n][q] + bf2f((unsigned short)mb[q]) * acc2[m][n][q];
                st_bf16x4(MG + o + 16 * n, v);
            }
        }
    }
}
DI void phase_wout(const Params& p, int l, LAS char* lds) {
    const int tid = opaque_tid(), lane = tid & 63, wid = tid >> 6, wm = wid >> 1, wn = wid & 1, fr = lane & 15, fq = lane >> 4;
    int R0, C0; thread_rc(tid, R0, C0);
    char* R = p.ws + O_R;
    const bf16_t* A = (const bf16_t*)(R + R_MERGED); const bf16_t* Bt = (const bf16_t*)(p.ws + O_WOUT) + (size_t)l * D * D;
    const float* xin = (l == 0) ? p.in[I_X] : (const float*)(p.ws + O_XF2); float* Y = (float*)(R + R_YPRE);
    for (int u = blockIdx.x; u < 128 * 8; u += gridDim.x) {
        const int rt = u >> 3, ct = u & 7;
        const bf16_t* ap[4]; const bf16_t* bp[2];
#pragma unroll
        for (int i = 0; i < 4; ++i) ap[i] = A + (size_t)(rt * 256 + R0 + 64 * i) * D + C0;
#pragma unroll
        for (int i = 0; i < 2; ++i) bp[i] = Bt + (size_t)(ct * 128 + R0 + 64 * i) * D + C0;
        f32x4 acc[4][4]; zero_acc(acc);
        gemm_kloop<4, 2>(acc, ap, bp, D / 64, lds, tid);
#pragma unroll
        for (int m = 0; m < 4; ++m) {
            const size_t o = (size_t)(rt * 256 + wm * 64 + 16 * m + fr) * D + ct * 128 + wn * 64 + 4 * fq;
#pragma unroll
            for (int n = 0; n < 4; ++n) { const f32x4 xv = *(const f32x4*)(xin + o + 16 * n); *(f32x4*)(Y + o + 16 * n) = xv * ALPHA + acc[m][n]; }
        }
    }
}
DI void ln_row_store(float (&v)[16], const float* g, const float* bta, float* outf, bf16_t* outb, int lane, unsigned char* out8 = nullptr) {
    float s = 0.f;
#pragma unroll
    for (int i = 0; i < 16; ++i) s += v[i];
#pragma unroll
    for (int m = 1; m < 64; m <<= 1) s += shx(s, m);
    const float mean = s * (1.0f / 1024.0f);
    float q = 0.f;
#pragma unroll
    for (int i = 0; i < 16; ++i) { const float d = v[i] - mean; q += d * d; }
#pragma unroll
    for (int m = 1; m < 64; m <<= 1) q += shx(q, m);
    const float rstd = rsqrtf(q * (1.0f / 1024.0f) + LN_EPS);
#pragma unroll
    for (int hlf = 0; hlf < 2; ++hlf) {
        const int c0 = hlf * 512 + 8 * lane;
        const f32x4 g0 = *(const f32x4*)(g + c0), g1 = *(const f32x4*)(g + c0 + 4), b0 = *(const f32x4*)(bta + c0), b1 = *(const f32x4*)(bta + c0 + 4);
        f32x4 y0, y1;
#pragma unroll
        for (int j = 0; j < 4; ++j) { y0[j] = (v[hlf * 8 + j] - mean) * rstd * g0[j] + b0[j]; y1[j] = (v[hlf * 8 + 4 + j] - mean) * rstd * g1[j] + b1[j]; }
        if (outf) { *(f32x4*)(outf + c0) = y0; *(f32x4*)(outf + c0 + 4) = y1; }
        if (outb) { u32x4 wv; wv.x = pk2(y0[0], y0[1]); wv.y = pk2(y0[2], y0[3]); wv.z = pk2(y1[0], y1[1]); wv.w = pk2(y1[2], y1[3]); *(u32x4*)(outb + c0) = wv; }
        if (out8) { u32x2 w8; w8.x = pk4_fp8(y0[0] * XS8, y0[1] * XS8, y0[2] * XS8, y0[3] * XS8); w8.y = pk4_fp8(y1[0] * XS8, y1[1] * XS8, y1[2] * XS8, y1[3] * XS8); *(u32x2*)(out8 + c0) = w8; }
    }
}
DI void phase_ln1(const Params& p, int l) {
    const int tid = opaque_tid(), lane = tid & 63, gw = blockIdx.x * 8 + (tid >> 6), nw = gridDim.x * 8;
    const bf16_t* Y = (const bf16_t*)(p.ws + O_R + R_YPRE); bf16_t* XB = (bf16_t*)(p.ws + O_XB1);
    const float* g = p.in[I_LN1G] + (size_t)l * D; const float* bta = p.in[I_LN1B] + (size_t)l * D;
    for (int row = gw; row < NT; row += nw) {
        float v[16];
#pragma unroll
        for (int hlf = 0; hlf < 2; ++hlf) { const bf16x8 a = *(const bf16x8*)(Y + (size_t)row * D + hlf * 512 + 8 * lane);
#pragma unroll
            for (int j = 0; j < 8; ++j) v[hlf * 8 + j] = bf2f((unsigned short)a[j]); }
        ln_row_store(v, g, bta, nullptr, XB + (size_t)row * D, lane, F8_M1 ? (unsigned char*)(p.ws + O_XA8) + (size_t)row * D : nullptr);
    }
    int* rt = (int*)(p.ws + O_ROWTOK);
    for (size_t i = (size_t)blockIdx.x * NTHREADS + tid; i < (size_t)MAXROWS + 256; i += (size_t)gridDim.x * NTHREADS) rt[i] = 0;
}
DI void phase_router(const Params& p, int l, LAS char* lds) {
    const int tid = opaque_tid(), lane = tid & 63, wid = tid >> 6, wm = wid >> 1, wn = wid & 1, fr = lane & 15, fq = lane >> 4;
    int R0, C0; thread_rc(tid, R0, C0);
    const bf16_t* A = (const bf16_t*)(p.ws + O_XB1); const bf16_t* Bt = (const bf16_t*)(p.ws + O_WR) + (size_t)l * NE * D; float* LG = (float*)(p.ws + O_LOGIT);
    for (int u = blockIdx.x; u < 128 * 2; u += gridDim.x) {
        const int rt = u >> 1, ct = u & 1;
        const bf16_t* ap[4]; const bf16_t* bp[2];
#pragma unroll
        for (int i = 0; i < 4; ++i) ap[i] = A + (size_t)(rt * 256 + R0 + 64 * i) * D + C0;
#pragma unroll
        for (int i = 0; i < 2; ++i) bp[i] = Bt + (size_t)(ct * 128 + R0 + 64 * i) * D + C0;
        f32x4 acc[4][4]; zero_acc(acc);
        gemm_kloop<4, 2>(acc, ap, bp, D / 64, lds, tid);
#pragma unroll
        for (int m = 0; m < 4; ++m) {
            const size_t o = (size_t)(rt * 256 + wm * 64 + 16 * m + fr) * NE + ct * 128 + wn * 64 + 4 * fq;
#pragma unroll
            for (int n = 0; n < 4; ++n) *(f32x4*)(LG + o + 16 * n) = acc[m][n];
        }
    }
}
DI void phase_routing(const Params& p, int l, LAS char* lds, int var = 0) {
    const int tid = opaque_tid(), lane = tid & 63, w = tid >> 6;
    LAS unsigned* hist = (LAS unsigned*)lds; LAS unsigned* base = hist + 256; LAS unsigned* loc = hist + 512; LAS float* biasL = (LAS float*)(hist + 1536);
    const float* LG = (const float*)(p.ws + O_LOGIT); const float* rb = p.in[I_RB] + (size_t)l * NE;
    int* TOPI = (int*)(p.ws + O_TOPI); float* GATE = (float*)(p.ws + O_GATE); int* POS = (int*)(p.ws + O_POS);
    unsigned* CNT = (unsigned*)(p.ws + O_CNT) + l * NE;
    for (int tb = blockIdx.x; tb < NT / 128; tb += gridDim.x) {
    __syncthreads();
    if (tid < 256) { hist[tid] = 0u; biasL[tid] = rb[tid]; }
    __syncthreads();
    if (w < 2) {
        const int t = tb * 128 + w * 64 + lane;
        const float* row = LG + (size_t)t * NE;
        float gs[8];
#pragma unroll
        for (int g = 0; g < 8; ++g) {
            float a1 = -INFINITY, a2 = -INFINITY;
#pragma unroll
            for (int j4 = 0; j4 < 8; ++j4) {
                const f32x4 lg = *(const f32x4*)(row + g * 32 + j4 * 4); const f32x4 bb = *(LAS const f32x4*)(biasL + g * 32 + j4 * 4);
#pragma unroll
                for (int q = 0; q < 4; ++q) { const float v = frcp(1.0f + __expf(-lg[q])) + bb[q]; const float n1 = fmaxf(a1, v), n2 = fmaxf(a2, fminf(a1, v)); a1 = n1; a2 = n2; }
            }
            gs[g] = a1 + a2;
        }
        int sel[8], pos[8];
#pragma unroll
        for (int g = 0; g < 8; ++g) { int rk = 0;
#pragma unroll
            for (int g2 = 0; g2 < 8; ++g2) rk += (g2 != g && (gs[g2] > gs[g] || (gs[g2] == gs[g] && g2 < g))) ? 1 : 0;
            sel[g] = rk < 4; }
        { int c = 0;
#pragma unroll
          for (int g = 0; g < 8; ++g) { pos[g] = c; c += sel[g]; } }
        float lv[8]; int li[8];
#pragma unroll
        for (int k = 0; k < 8; ++k) { lv[k] = -INFINITY; li[k] = 0; }
#pragma unroll
        for (int k = 0; k < 4; ++k) {
            int g = 0;
#pragma unroll
            for (int g2 = 0; g2 < 8; ++g2) g = (sel[g2] && pos[g2] == k) ? g2 : g;
#pragma unroll
            for (int j4 = 0; j4 < 8; ++j4) {
                const f32x4 lg = *(const f32x4*)(row + g * 32 + j4 * 4); const f32x4 bb = *(LAS const f32x4*)(biasL + g * 32 + j4 * 4);
#pragma unroll
                for (int q = 0; q < 4; ++q) {
                    float v = frcp(1.0f + __expf(-lg[q])) + bb[q]; int e = g * 32 + j4 * 4 + q;
                    if (v > lv[7]) {
                        lv[7] = v; li[7] = e;
#pragma unroll
                        for (int k2 = 7; k2 > 0; --k2) { const bool sw = lv[k2] > lv[k2 - 1]; const float tv = lv[k2]; const int ti = li[k2];
                            lv[k2] = sw ? lv[k2 - 1] : lv[k2]; li[k2] = sw ? li[k2 - 1] : li[k2]; lv[k2 - 1] = sw ? tv : lv[k2 - 1]; li[k2 - 1] = sw ? ti : li[k2 - 1]; }
                    }
                }
            }
        }
        float sc8[8], ssum = 0.f;
#pragma unroll
        for (int k = 0; k < 8; ++k) { sc8[k] = lv[k] - biasL[li[k]]; ssum += sc8[k]; }
        const float rs = 2.5f * frcp(ssum);
        int* ti = TOPI + (size_t)t * 8; float* gt = GATE + (size_t)t * 8;
#pragma unroll
        for (int k = 0; k < 8; ++k) { ti[k] = li[k]; gt[k] = sc8[k] * rs; }
        if (var != 1) {
#pragma unroll
            for (int k = 0; k < 8; ++k) { const unsigned rk = __hip_atomic_fetch_add(&hist[li[k]], 1u, __ATOMIC_RELAXED, __HIP_MEMORY_SCOPE_WORKGROUP); loc[(w * 64 + lane) * 8 + k] = ((unsigned)li[k] << 16) | rk; }
        }
    }
    __syncthreads();
    if (var != 1) {
    if (tid < 256) { const unsigned c = hist[tid]; base[tid] = c ? atomicAdd(&CNT[tid], c) : 0u; }
    __syncthreads();
    for (int i = tid; i < 1024; i += NTHREADS) { const unsigned v = loc[i]; POS[tb * 1024 + i] = (int)(base[v >> 16] + (v & 0xffffu)); }
    }
    }
}
DI void phase_dispatch(const Params& p, int l, LAS char* lds) {
    const int tid = opaque_tid();
    LAS int* sc = (LAS int*)lds;
    const unsigned* CNT = (const unsigned*)(p.ws + O_CNT) + l * NE;
    int pad = 0;
    __syncthreads();
    if (tid < NE) { pad = ((int)CNT[tid] + 127) & ~127; sc[tid] = pad; }
    __syncthreads();
    for (int d = 1; d < NE; d <<= 1) {
        int v = 0;
        if (tid < NE && tid >= d) v = sc[tid - d];
        __syncthreads();
        if (tid < NE) sc[tid] += v;
        __syncthreads();
    }
    if (blockIdx.x == 0) {
        int* TE = (int*)(p.ws + O_TILEE);
        if (tid < NE) { const int pe = sc[tid], ps = pe - pad; for (int r = ps; r < pe; r += 128) TE[r >> 7] = tid; if (tid == NE - 1) ((int*)(p.ws + O_MISC))[l] = pe >> 7; }
    }
    const int* TOPI = (const int*)(p.ws + O_TOPI); const int* POS = (const int*)(p.ws + O_POS); int* SLOT = (int*)(p.ws + O_SLOT); int* RT = (int*)(p.ws + O_ROWTOK);
    for (size_t a = (size_t)blockIdx.x * NTHREADS + tid; a < (size_t)NT * TOPK; a += (size_t)gridDim.x * NTHREADS) {
        const int e = TOPI[a]; const int ps = (e > 0) ? sc[e - 1] : 0;
        const int dest = ps + POS[a];
        RT[dest] = (int)(a >> 3); SLOT[a] = dest;
    }
}
DI void phase_moe1(const Params& p, int l, LAS char* lds) {
    const int tid = opaque_tid(), lane = tid & 63, wid = tid >> 6, wm = wid >> 2, wn = wid & 3, fr = lane & 15, fq = lane >> 4;
    int R0, C0; thread_rc(tid, R0, C0);
    const int ntr = ((const int*)(p.ws + O_MISC))[l];
    const int* RT = (const int*)(p.ws + O_ROWTOK); const int* TE = (const int*)(p.ws + O_TILEE);
    const bf16_t* X = (const bf16_t*)(p.ws + O_XB1); bf16_t* H = (bf16_t*)(p.ws + O_H);
    const bf16_t* WGU = (const bf16_t*)(p.ws + O_WGU); const bf16_t* WS = (const bf16_t*)(p.ws + O_WSGU) + (size_t)l * 512 * D;
    for (int u = blockIdx.x; u < (ntr + 256) * 2; u += gridDim.x) {
        const int ti = u >> 1, ct = u & 1;
        const bool routed = ti < ntr;
        const int hrow0 = routed ? ti * 128 : MAXROWS + (ti - ntr) * 128;
        const bf16_t* W = routed ? WGU + (size_t)TE[ti] * 512 * D : WS;
        const bf16_t* ap[2]; const bf16_t* bp[4];
#pragma unroll
        for (int i = 0; i < 2; ++i) { const int rr = R0 + 64 * i; const int tok = routed ? RT[ti * 128 + rr] : (ti - ntr) * 128 + rr; ap[i] = X + (size_t)tok * D + C0; }
#pragma unroll
        for (int i = 0; i < 4; ++i) bp[i] = W + (size_t)(ct * 256 + R0 + 64 * i) * D + C0;
        f32x4 acc[4][4]; zero_acc(acc);
        gemm_kloop<2, 4>(acc, ap, bp, D / 64, lds, tid);
#pragma unroll
        for (int m = 0; m < 4; ++m) {
            bf16_t* hr = H + (size_t)(hrow0 + wm * 64 + 16 * m + fr) * DE + ct * 128 + wn * 32 + 4 * fq;
#pragma unroll
            for (int jn = 0; jn < 2; ++jn) {
                const f32x4 gv = acc[m][2 * jn], uv = acc[m][2 * jn + 1]; f32x4 hv;
#pragma unroll
                for (int q = 0; q < 4; ++q) hv[q] = gv[q] * frcp(1.0f + __expf(-gv[q])) * uv[q];
                st_bf16x4(hr + 16 * jn, hv);
            }
        }
    }
}
DI void phase_moe2(const Params& p, int l, LAS char* lds) {
    const int tid = opaque_tid(), lane = tid & 63, wid = tid >> 6, wm = wid >> 2, wn = wid & 3, fr = lane & 15, fq = lane >> 4;
    int R0, C0; thread_rc(tid, R0, C0);
    const int ntr = ((const int*)(p.ws + O_MISC))[l];
    const int* TE = (const int*)(p.ws + O_TILEE);
    const bf16_t* H = (const bf16_t*)(p.ws + O_H); bf16_t* Y = (bf16_t*)(p.ws + O_R);
    const bf16_t* WDN = (const bf16_t*)(p.ws + O_WDN); const bf16_t* WS = (const bf16_t*)(p.ws + O_WSD) + (size_t)l * D * DE;
    for (int u = blockIdx.x; u < (ntr + 256) * 4; u += gridDim.x) {
        const int ti = u >> 2, ct = u & 3;
        const bool routed = ti < ntr;
        const int hrow0 = routed ? ti * 128 : MAXROWS + (ti - ntr) * 128;
        const bf16_t* W = routed ? WDN + (size_t)TE[ti] * D * DE : WS;
        const bf16_t* ap[2]; const bf16_t* bp[4];
#pragma unroll
        for (int i = 0; i < 2; ++i) ap[i] = H + (size_t)(hrow0 + R0 + 64 * i) * DE + C0;
#pragma unroll
        for (int i = 0; i < 4; ++i) bp[i] = W + (size_t)(ct * 256 + R0 + 64 * i) * DE + C0;
        f32x4 acc[4][4]; zero_acc(acc);
        gemm_kloop<2, 4>(acc, ap, bp, DE / 64, lds, tid);
#pragma unroll
        for (int m = 0; m < 4; ++m) {
            bf16_t* yr = Y + (size_t)(hrow0 + wm * 64 + 16 * m + fr) * D + ct * 256 + wn * 64 + 4 * fq;
#pragma unroll
            for (int n = 0; n < 4; ++n) st_bf16x4(yr + 16 * n, acc[m][n]);
        }
    }
}
DI void phase_combine(const Params& p, int l, int var = 0) {
    const int tid = opaque_tid(), lane = tid & 63, gw = blockIdx.x * 8 + (tid >> 6), nw = gridDim.x * 8;
    const unsigned char* Y = (const unsigned char*)(p.ws + O_R); const bf16_t* X1 = (const bf16_t*)(p.ws + O_XB1);
    const int* SLOT = (const int*)(p.ws + O_SLOT); const float* GATE = (const float*)(p.ws + O_GATE);
    const float* g = p.in[I_LN2G] + (size_t)l * D; const float* bta = p.in[I_LN2B] + (size_t)l * D;
    float* outf = (l == NL - 1) ? p.out : nullptr; bf16_t* outb = (l == NL - 1) ? nullptr : (bf16_t*)(p.ws + (var == 1 ? O_XB0 : O_XB1));
    for (int t0 = gw * 2; t0 < NT; t0 += nw * 2) {
        float v[2][16]; int slot[2]; float gt[2];
#pragma unroll
        for (int u = 0; u < 2; ++u) {
            const int t = t0 + u;
            slot[u] = 0; gt[u] = 0.f;
            if (lane < 8) { slot[u] = SLOT[t * 8 + lane]; gt[u] = GATE[t * 8 + lane]; }
#pragma unroll
            for (int hlf = 0; hlf < 2; ++hlf) { const bf16x8 a = *(const bf16x8*)(X1 + (size_t)t * D + hlf * 512 + 8 * lane);
#pragma unroll
                for (int j = 0; j < 8; ++j) v[u][hlf * 8 + j] = bf2f((unsigned short)a[j]) * ALPHA; }
        }
#pragma unroll
        for (int k = 0; k < 9; ++k) {
#pragma unroll
            for (int u = 0; u < 2; ++u) {
                const int t = t0 + u;
                const int row = (k < 8) ? __shfl(slot[u], k) : MAXROWS + t; const float gk = ((k < 8) ? __shfl(gt[u], k) : 1.0f) * (1.0f / 16.0f);
#pragma unroll
                for (int hlf = 0; hlf < 2; ++hlf) { const u32x2 yv = *(const u32x2*)(Y + (size_t)row * D + hlf * 512 + 8 * lane);
                    const f32x2 a0 = __builtin_amdgcn_cvt_pk_f32_fp8((int)yv.x, false), a1 = __builtin_amdgcn_cvt_pk_f32_fp8((int)yv.x, true);
                    const f32x2 a2 = __builtin_amdgcn_cvt_pk_f32_fp8((int)yv.y, false), a3 = __builtin_amdgcn_cvt_pk_f32_fp8((int)yv.y, true);
                    v[u][hlf * 8 + 0] += gk * a0.x; v[u][hlf * 8 + 1] += gk * a0.y; v[u][hlf * 8 + 2] += gk * a1.x; v[u][hlf * 8 + 3] += gk * a1.y;
                    v[u][hlf * 8 + 4] += gk * a2.x; v[u][hlf * 8 + 5] += gk * a2.y; v[u][hlf * 8 + 6] += gk * a3.x; v[u][hlf * 8 + 7] += gk * a3.y; }
            }
        }
#pragma unroll
        for (int u = 0; u < 2; ++u) { const int t = t0 + u; ln_row_store(v[u], g, bta, outf ? outf + (size_t)t * D : nullptr, outb ? outb + (size_t)t * D : nullptr, lane, (F8_P1 && outb) ? (unsigned char*)(p.ws + O_XA8) + (size_t)t * D : nullptr); }
    }
}

DI int lds_byte(int r, int c) { const int st = (r >> 4) * 2 + (c >> 5), rr = r & 15, cc = c & 31, ob = rr * 64 + cc * 2; return st * 1024 + (ob ^ (((ob >> 9) & 1) << 5)); }
struct GUnit { unsigned A, B; int pm, pn, x0, x1; };
DI int xcd_remap(int L, int nwg) { const int q = nwg >> 3, r = nwg & 7, xcd = L & 7, off = L >> 3; return (xcd < r ? xcd * (q + 1) : r * (q + 1) + (xcd - r) * q) + off; }
constexpr int HTB = 16384;

template <bool F8> DI f32x4 g8_mfma(const bf16x8 (&b)[2], const bf16x8 (&a)[2], f32x4 c) {
    if constexpr (F8) {
        const i32x8 a8 = __builtin_shufflevector(__builtin_bit_cast(i32x4, a[0]), __builtin_bit_cast(i32x4, a[1]), 0, 1, 2, 3, 4, 5, 6, 7);
        const i32x8 b8 = __builtin_shufflevector(__builtin_bit_cast(i32x4, b[0]), __builtin_bit_cast(i32x4, b[1]), 0, 1, 2, 3, 4, 5, 6, 7);
        return __builtin_amdgcn_mfma_scale_f32_16x16x128_f8f6f4(b8, a8, c, 0, 0, 0, 0, 0, 0);
    } else {
        c = __builtin_amdgcn_mfma_f32_16x16x32_bf16(b[0], a[0], c, 0, 0, 0);
        return __builtin_amdgcn_mfma_f32_16x16x32_bf16(b[1], a[1], c, 0, 0, 0);
    }
}
template <bool F8, class Sched, class Epi>
DI void gemm8(LAS char* lds, const char* wsbase, const int K, const Sched& S, const Epi& E, const int tid) {
    const int wid = __builtin_amdgcn_readfirstlane(tid >> 6), lane = tid & 63, wr = wid >> 2, wc = wid & 3, fr = lane & 15, fq = lane >> 4;
    const int nt = K / 64;
    const __amdgpu_buffer_rsrc_t rs = __builtin_amdgcn_make_buffer_rsrc((void*)wsbase, 0, 0xffffffffu, 0x00020000);
    unsigned voffB0;
    { int Rr, Cc; stage_rc(tid * 16, Rr, Cc); const int rho = Rr & 31, Rb = (Rr & ~31) + 8 * ((rho & 15) >> 2) + 4 * (rho >> 4) + (rho & 3);
        voffB0 = (unsigned)(Rb * K + Cc) * 2u; }
    const unsigned rstep64 = 128u * (unsigned)K;
    constexpr bool GA = Sched::kGather;
    unsigned oA0 = 0u;
    if constexpr (!GA) { int Rr, Cc; stage_rc(tid * 16, Rr, Cc); oA0 = (unsigned)(Rr * K + Cc) * 2u; }
    const unsigned kstep = 128u, hstepB = 128u * (unsigned)K * 2u;
    const unsigned ldsw = (unsigned)wid * 1024u;
    const int aoff = lds_byte(wr * 64 + fr, fq * 8), boff = lds_byte(wc * 32 + fr, fq * 8);
#define G8_SA(b, h) (((b) * 2 + (h)) * HTB)
#define G8_SB(b, h) ((4 + (b) * 2 + (h)) * HTB)
#define G8_STAGE(bufoff, s0, s1, o0, o1) do { \
        __builtin_amdgcn_raw_ptr_buffer_load_lds(rs, (LAS void*)(lds + (bufoff) + ldsw), 16, (int)(o0), (int)(s0), 0, 0); \
        __builtin_amdgcn_raw_ptr_buffer_load_lds(rs, (LAS void*)(lds + (bufoff) + ldsw + 8192), 16, (int)(o1), (int)(s1), 0, 0); } while (0)
#define G8_STAGEB(bufoff, sbase) G8_STAGE(bufoff, sbase, (sbase) + rstep64, voffB0, voffB0)
#define G8_STAGEA(bufoff, sbase, h, q0, q1) do { if constexpr (GA) G8_STAGE(bufoff, sbase, sbase, q0, q1); \
        else G8_STAGE(bufoff, (sbase) + (h) * 2u * rstep64, (sbase) + (h) * 2u * rstep64 + rstep64, oA0, oA0); } while (0)
#define G8_LDA(dst, b, h) do { _Pragma("unroll") for (int m = 0; m < 4; ++m) _Pragma("unroll") for (int k = 0; k < 2; ++k) dst[m][k] = *(const LAS bf16x8*)(lds + G8_SA(b, h) + aoff + m * 2048 + k * 1024); } while (0)
#define G8_LDB(dst, b, h) do { _Pragma("unroll") for (int n = 0; n < 2; ++n) _Pragma("unroll") for (int k = 0; k < 2; ++k) dst[n][k] = *(const LAS bf16x8*)(lds + G8_SB(b, h) + boff + n * 2048 + k * 1024); } while (0)
#define G8_MMA(ai, bj, At, Bt) do { __builtin_amdgcn_s_setprio(1); _Pragma("unroll") for (int m = 0; m < 4; ++m) _Pragma("unroll") for (int n = 0; n < 2; ++n) \
        acc[ai][bj][m][n] = g8_mfma<F8>(Bt[n], At[m], acc[ai][bj][m][n]); __builtin_amdgcn_s_setprio(0); } while (0)
#define G8_WAIT_V(n) asm volatile("s_waitcnt vmcnt(" #n ")" ::: "memory")
#define G8_WAIT_L(n) asm volatile("s_waitcnt lgkmcnt(" #n ")" ::: "memory")
#define G8_BAR __builtin_amdgcn_s_barrier()
#define G8_SCHED __builtin_amdgcn_sched_barrier(0)
    GUnit cur, nxt; int ui = 0;
    if (!S.next(0, cur)) return;
    unsigned oA[2][2], nA_[2][2];
    if constexpr (GA) S.aoffs(cur, tid, K, oA);
    else {
#pragma unroll
        for (int h = 0; h < 2; ++h)
#pragma unroll
            for (int i = 0; i < 2; ++i) { oA[h][i] = 0u; nA_[h][i] = 0u; }
    }
    f32x4 acc[2][2][4][2];
#pragma unroll
    for (int a = 0; a < 2; ++a)
#pragma unroll
        for (int b = 0; b < 2; ++b)
#pragma unroll
            for (int m = 0; m < 4; ++m)
#pragma unroll
                for (int n = 0; n < 2; ++n) acc[a][b][m][n] = (f32x4){0.f, 0.f, 0.f, 0.f};
    bf16x8 At[4][2], B0[2][2], B1[2][2];
    unsigned cA = cur.A, cB = cur.B;
    G8_STAGEB(G8_SB(0, 0), cB); G8_STAGEB(G8_SB(0, 1), cB + hstepB); G8_STAGEA(G8_SA(0, 0), cA, 0, oA[0][0], oA[0][1]); G8_STAGEA(G8_SA(0, 1), cA, 1, oA[1][0], oA[1][1]);
    if (wr == 1) G8_BAR;
    G8_WAIT_V(2); G8_BAR;
    G8_STAGEB(G8_SB(1, 0), cB + kstep); G8_STAGEA(G8_SA(1, 0), cA + kstep, 0, oA[0][0], oA[0][1]); G8_STAGEB(G8_SB(1, 1), cB + hstepB + kstep);
    G8_WAIT_V(6); G8_BAR;
    for (;;) {
        const bool has_next = S.next(ui + 1, nxt);
        const unsigned nA = has_next ? nxt.A : cA, nB = has_next ? nxt.B : cB;
        if constexpr (!GA) {}
        else if (has_next) S.aoffs(nxt, tid, K, nA_);
        else {
#pragma unroll
            for (int h = 0; h < 2; ++h)
#pragma unroll
                for (int i = 0; i < 2; ++i) nA_[h][i] = oA[h][i];
        }
        const bool hi = cur.x1 != 1;
#pragma unroll 1
        for (int t = 0; t < nt; t += 2) {
            const bool last = (t == nt - 2);
            const unsigned a1 = cA + (unsigned)(t + 1) * kstep;
            const unsigned a2 = last ? nA : cA + (unsigned)(t + 2) * kstep, b2 = last ? nB : cB + (unsigned)(t + 2) * kstep;
            const unsigned a3 = a2 + kstep, b3 = b2 + kstep;
            const unsigned p00 = last ? nA_[0][0] : oA[0][0], p01 = last ? nA_[0][1] : oA[0][1], p10 = last ? nA_[1][0] : oA[1][0], p11 = last ? nA_[1][1] : oA[1][1];
            G8_LDB(B0, 0, 0); G8_LDB(B1, 0, 1); G8_SCHED; G8_LDA(At, 0, 0); G8_STAGEA(G8_SA(1, 1), a1, 1, oA[1][0], oA[1][1]);
            G8_WAIT_V(8); G8_WAIT_L(0); G8_BAR; G8_MMA(0, 0, At, B0); G8_MMA(0, 1, At, B1); G8_BAR; G8_SCHED;
            G8_LDA(At, 0, 1); G8_STAGEB(G8_SB(0, 0), b2); G8_STAGEB(G8_SB(0, 1), b2 + hstepB); G8_STAGEA(G8_SA(0, 0), a2, 0, p00, p01);
            G8_WAIT_V(8); G8_WAIT_L(0); G8_BAR; if (hi) { G8_MMA(1, 0, At, B0); G8_MMA(1, 1, At, B1); } G8_BAR; G8_SCHED;
            G8_LDB(B0, 1, 0); G8_LDB(B1, 1, 1); G8_SCHED; G8_LDA(At, 1, 0); G8_STAGEA(G8_SA(0, 1), a2, 1, p10, p11);
            G8_WAIT_V(8); G8_WAIT_L(0); G8_BAR; G8_MMA(0, 0, At, B0); G8_MMA(0, 1, At, B1); G8_BAR; G8_SCHED;
            G8_LDA(At, 1, 1); G8_STAGEB(G8_SB(1, 0), b3); G8_STAGEB(G8_SB(1, 1), b3 + hstepB); G8_STAGEA(G8_SA(1, 0), a3, 0, p00, p01);
            G8_WAIT_V(8); G8_WAIT_L(0); G8_BAR; if (hi) { G8_MMA(1, 0, At, B0); G8_MMA(1, 1, At, B1); } G8_BAR; G8_SCHED;
        }
        if (wr == 0) G8_BAR;
        const int te_ = opaque_tid(); const int fr_ = te_ & 15, fq_ = (te_ >> 4) & 3;
        const bool keep = E(acc, cur, wr, wc, fr_, fq_);
        if (!has_next) break;
        if (!keep) {
#pragma unroll
            for (int a = 0; a < 2; ++a)
#pragma unroll
                for (int b = 0; b < 2; ++b)
#pragma unroll
                    for (int m = 0; m < 4; ++m)
#pragma unroll
                        for (int n = 0; n < 2; ++n) acc[a][b][m][n] = (f32x4){0.f, 0.f, 0.f, 0.f};
        }
        cur = nxt; cA = nA; cB = nB; ++ui;
#pragma unroll
        for (int h = 0; h < 2; ++h)
#pragma unroll
            for (int i = 0; i < 2; ++i) oA[h][i] = nA_[h][i];
        if (wr == 1) G8_BAR;
    }
    G8_WAIT_V(0);
    G8_BAR;
#undef G8_SA
#undef G8_SB
#undef G8_STAGE
#undef G8_STAGEB
#undef G8_STAGEA
#undef G8_LDA
#undef G8_LDB
#undef G8_MMA
#undef G8_WAIT_V
#undef G8_WAIT_L
#undef G8_BAR
#undef G8_SCHED
}

struct DenseSched {
    static constexpr bool kGather = false;
    unsigned A, B; int nM, nN, nwg, G, c; unsigned tstep;
    DI void init(size_t A_, size_t B_, int M, int N, int K) { A = (unsigned)A_; B = (unsigned)B_; nM = M / 256; nN = N / 256; nwg = nM * nN; G = gridDim.x; c = blockIdx.x; tstep = 256u * (unsigned)K * 2u; }
    DI void tile(int L, int& pm, int& pn) const {
        const int wgid = xcd_remap(L, nwg);
        const int nig = 8 * nN, gid = wgid / nig, fm = gid * 8, gsz = (nM - fm) < 8 ? (nM - fm) : 8;
        pm = fm + ((wgid % nig) % gsz); pn = (wgid % nig) / gsz;
    }
    DI bool next(int i, GUnit& u) const {
        const long L = (long)i * G + c; if (L >= nwg) return false;
        tile((int)L, u.pm, u.pn); u.A = A + (unsigned)u.pm * tstep; u.B = B + (unsigned)u.pn * tstep; u.x0 = 0; u.x1 = 0; return true;
    }
    DI void aoffs(const GUnit&, int tid, int K, unsigned (&o)[2][2]) const {
        int R[2], C[2]; stage_rc(tid * 16, R[0], C[0]); stage_rc(tid * 16 + 8192, R[1], C[1]);
#pragma unroll
        for (int h = 0; h < 2; ++h)
#pragma unroll
            for (int i = 0; i < 2; ++i) o[h][i] = (unsigned)((128 * h + R[i]) * K + C[i]) * 2u;
    }
};
struct PairSched : DenseSched {
    unsigned A1, B1;
    DI bool next(int i, GUnit& u) const {
        const long L = (long)(i >> 1) * G + c; if (L >= nwg) return false;
        tile((int)L, u.pm, u.pn); const int st = i & 1;
        u.A = (st ? A1 : A) + (unsigned)u.pm * tstep; u.B = (st ? B1 : B) + (unsigned)u.pn * tstep; u.x0 = st; u.x1 = 0; return true;
    }
};
struct MoeSched {
    static constexpr bool kGather = true;
    unsigned X, Wr, Ws; const int* TE; const int* TR0; const int* TNH; const int* RT;
    int ntr, ncol, nunits, G, c, K; unsigned wexp, wtile; bool gather;
    DI bool next(int i, GUnit& u) const {
        const long L = (long)i * G + c; if (L >= nunits) return false;
        const int wgid = xcd_remap((int)L, nunits), ti = wgid / ncol; u.pn = wgid % ncol;
        if (ti < ntr) { const int e = TE[ti]; u.x0 = TR0[ti]; u.x1 = TNH[ti]; u.pm = -1; u.B = Wr + (unsigned)e * wexp + (unsigned)u.pn * wtile; u.A = gather ? X : X + (unsigned)u.x0 * (unsigned)K * 2u; }
        else { const int st = ti - ntr; u.x0 = MAXROWS + 256 * st; u.x1 = 2; u.pm = st; u.B = Ws + (unsigned)u.pn * wtile; u.A = gather ? X + (unsigned)st * 256u * (unsigned)K * 2u : X + (unsigned)u.x0 * (unsigned)K * 2u; }
        return true;
    }
    DI void aoffs(const GUnit& u, int tid, int K_, unsigned (&o)[2][2]) const {
        int R[2], C[2]; stage_rc(tid * 16, R[0], C[0]); stage_rc(tid * 16 + 8192, R[1], C[1]);
        if (gather && u.pm < 0) {
#pragma unroll
            for (int h = 0; h < 2; ++h)
#pragma unroll
                for (int i = 0; i < 2; ++i) o[h][i] = (unsigned)(RT[u.x0 + 128 * h + R[i]] * K_ + C[i]) * 2u;
        } else {
#pragma unroll
            for (int h = 0; h < 2; ++h)
#pragma unroll
                for (int i = 0; i < 2; ++i) o[h][i] = (unsigned)((128 * h + R[i]) * K_ + C[i]) * 2u;
        }
    }
};

struct EpiProj {
    const Params* pp; int l; float ds;
    DI bool operator()(f32x4 (&acc)[2][2][4][2], const GUnit& u, int wr, int wc, int fr, int fq) const {
        const Params& p = *pp; char* R = p.ws + O_R;
        const int pn = u.pn;
        const float* bias = (const float*)(p.ws + O_BIASP) + (size_t)l * NP + pn * 256 + 32 * wc + 8 * fq;
        f32x4 bv[2][2];
#pragma unroll
        for (int bj = 0; bj < 2; ++bj)
#pragma unroll
            for (int n = 0; n < 2; ++n) bv[bj][n] = *(const f32x4*)(bias + 128 * bj + 4 * n);
        int kind, head = 0, H = 8; bf16_t* dst = nullptr;
        if (pn < 2) { kind = 0; head = 4 * pn + wc; }
        else if (pn < 5) { H = 2; head = wc & 1; const bool isv = wc >= 2; kind = (isv || pn == 2) ? 1 : 2;
            const size_t off = pn == 2 ? (isv ? R_VC : R_KC) : pn == 3 ? (isv ? R_VS : R_KS) : (isv ? R_VW : R_KW); dst = (bf16_t*)(R + off); }
        else if (pn < 11) { const int sec = (pn - 5) >> 1; head = 4 * ((pn - 5) & 1) + wc; kind = sec == 2 ? 1 : 2; dst = (bf16_t*)(R + (sec == 0 ? R_QB : sec == 1 ? R_KB : R_VB)); }
        else if (pn < 19) { kind = 3; dst = (bf16_t*)(R + R_MA); head = (pn - 11) * 128; }
        else kind = 4;
        const float qs = (pn < 2 || pn == 5 || pn == 6) ? SM_C : 1.0f;
        const float* COS = (const float*)(p.ws + O_COS); const float* SIN = (const float*)(p.ws + O_SIN);
#pragma unroll
        for (int ai = 0; ai < 2; ++ai)
#pragma unroll
            for (int m = 0; m < 4; ++m) {
                const int t = u.pm * 256 + 128 * ai + 64 * wr + 16 * m + fr, b = t >> 12, s = t & 4095;
                f32x4 lo[2], hi[2];
#pragma unroll
                for (int n = 0; n < 2; ++n) { lo[n] = (acc[ai][0][m][n] * ds + bv[0][n]) * qs; hi[n] = (acc[ai][1][m][n] * ds + bv[1][n]) * qs; }
                if (kind <= 2) {
                    const size_t o = ((size_t)((b * H + head) * SEQ + s)) * 64 + 8 * fq;
                    if (kind == 0 || kind == 2) {
                        f32x4 rl[2], rh[2];
#pragma unroll
                        for (int n = 0; n < 2; ++n) { const f32x4 cs = *(const f32x4*)(COS + s * 32 + 4 * n + 8 * fq), sn = *(const f32x4*)(SIN + s * 32 + 4 * n + 8 * fq);
                            rl[n] = lo[n] * cs - hi[n] * sn; rh[n] = hi[n] * cs + lo[n] * sn; }
                        if (kind == 0) { bf16_t* qa = (bf16_t*)(R + R_QA) + o; bf16_t* qar = (bf16_t*)(R + R_QAR) + o;
#pragma unroll
                            for (int n = 0; n < 2; ++n) { st_bf16x4e(qa + 4 * n, lo[n]); st_bf16x4e(qa + 32 + 4 * n, hi[n]); st_bf16x4e(qar + 4 * n, rl[n]); st_bf16x4e(qar + 32 + 4 * n, rh[n]); } }
                        else {
#pragma unroll
                            for (int n = 0; n < 2; ++n) { st_bf16x4e(dst + o + 4 * n, rl[n]); st_bf16x4e(dst + o + 32 + 4 * n, rh[n]); } }
                    } else {
#pragma unroll
                        for (int n = 0; n < 2; ++n) { st_bf16x4e(dst + o + 4 * n, lo[n]); st_bf16x4e(dst + o + 32 + 4 * n, hi[n]); }
                    }
                } else if (kind == 3) {
                    unsigned char* o = (unsigned char*)dst + (size_t)t * D + head + 32 * wc + 8 * fq;
                    int r0 = 0, r1 = 0, b0 = 0, b1 = 0; float rr[8], sb[8];
#pragma unroll
                    for (int n = 0; n < 2; ++n)
#pragma unroll
                        for (int q = 0; q < 4; ++q) { const float ea = __expf(-lo[n][q]), eb = __expf(-hi[n][q]); sb[4 * n + q] = frcp(1.0f + eb); rr[4 * n + q] = fminf((1.0f + eb) * frcp(1.0f + ea), 400.0f); }
                    r0 = __builtin_amdgcn_cvt_pk_fp8_f32(rr[0], rr[1], r0, false); r0 = __builtin_amdgcn_cvt_pk_fp8_f32(rr[2], rr[3], r0, true);
                    r1 = __builtin_amdgcn_cvt_pk_fp8_f32(rr[4], rr[5], r1, false); r1 = __builtin_amdgcn_cvt_pk_fp8_f32(rr[6], rr[7], r1, true);
                    b0 = __builtin_amdgcn_cvt_pk_fp8_f32(sb[0], sb[1], b0, false); b0 = __builtin_amdgcn_cvt_pk_fp8_f32(sb[2], sb[3], b0, true);
                    b1 = __builtin_amdgcn_cvt_pk_fp8_f32(sb[4], sb[5], b1, false); b1 = __builtin_amdgcn_cvt_pk_fp8_f32(sb[6], sb[7], b1, true);
                    u32x2 wr_; wr_.x = (unsigned)r0; wr_.y = (unsigned)r1; u32x2 wb_; wb_.x = (unsigned)b0; wb_.y = (unsigned)b1;
                    *(u32x2*)o = wr_; *(u32x2*)(o + (R_MB - R_MA)) = wb_;
                } else if (wc == 0) {
                    float* ga = (float*)(R + R_GA) + (size_t)t * 24;
#pragma unroll
                    for (int n = 0; n < 2; ++n)
#pragma unroll
                        for (int q = 0; q < 4; ++q) { const int cidx = 4 * n + 8 * fq + q; if (cidx < 24) ga[cidx] = sigmoidf_(lo[n][q]); }
                }
            }
        return false;
    }
};
DI void phase_proj8(const Params& p, int l, LAS char* lds) {
    const int tid = opaque_tid();
    if (blockIdx.x < 2 && tid < 128) {
        const int lw = 2 * l + blockIdx.x; const float* PART = (const float*)(p.ws + O_C1PART) + (size_t)lw * 64 * 128;
        float a = p.in[I_CB1][lw * 128 + tid];
        for (int kq = 0; kq < 64; ++kq) a += PART[kq * 128 + tid];
        ((float*)(p.ws + O_C1))[lw * 128 + tid] = a;
    }
    constexpr int Kb = F8_P1 ? D / 2 : D;
    DenseSched S; S.init(F8_P1 ? O_XA8 : (l == 0 ? O_XB0 : O_XB1), O_WIN + (size_t)l * NP * Kb * 2, NT, NP, Kb);
    EpiProj E{&p, l, F8_P1 ? 1.0f / (XS8 * WS8) : 1.0f};
    gemm8<F8_P1>(lds, p.ws, Kb, S, E, tid);
}
DI void fp8x8_to_f32(const u32x2 w, float (&g)[8]) {
    const f32x2 a0 = __builtin_amdgcn_cvt_pk_f32_fp8((int)w.x, false), a1 = __builtin_amdgcn_cvt_pk_f32_fp8((int)w.x, true), a2 = __builtin_amdgcn_cvt_pk_f32_fp8((int)w.y, false), a3 = __builtin_amdgcn_cvt_pk_f32_fp8((int)w.y, true);
    g[0] = a0.x; g[1] = a0.y; g[2] = a1.x; g[3] = a1.y; g[4] = a2.x; g[5] = a2.y; g[6] = a3.x; g[7] = a3.y;
}
struct EpiMerge {
    const unsigned char* RT8; const unsigned char* MB8; bf16_t* MG; unsigned char* MG8; float ds;
    DI bool operator()(f32x4 (&acc)[2][2][4][2], const GUnit& u, int wr, int wc, int fr, int fq) const {
        const int st = u.x0; const unsigned char* G8 = st == 0 ? RT8 : MB8;
#pragma unroll
        for (int ai = 0; ai < 2; ++ai)
#pragma unroll
            for (int m = 0; m < 4; ++m) {
                const size_t o = (size_t)(u.pm * 256 + 128 * ai + 64 * wr + 16 * m + fr) * D + u.pn * 256 + 32 * wc + 8 * fq;
#pragma unroll
                for (int bj = 0; bj < 2; ++bj) {
                    float g[8]; fp8x8_to_f32(*(const u32x2*)(G8 + o + 128 * bj), g);
                    if (st == 0) {
#pragma unroll
                        for (int q = 0; q < 4; ++q) { acc[ai][bj][m][0][q] *= g[q]; acc[ai][bj][m][1][q] *= g[4 + q]; }
                    } else {
                        f32x4 v0, v1;
#pragma unroll
                        for (int q = 0; q < 4; ++q) { v0[q] = acc[ai][bj][m][0][q] * g[q] * ds; v1[q] = acc[ai][bj][m][1][q] * g[4 + q] * ds; }
                        if (F8_P6) { u32x2 w8; w8.x = pk4_fp8(v0[0], v0[1], v0[2], v0[3]); w8.y = pk4_fp8(v1[0], v1[1], v1[2], v1[3]); *(u32x2*)(MG8 + o + 128 * bj) = w8; }
                        else { st_bf16x4e(MG + o + 128 * bj, v0); st_bf16x4e(MG + o + 128 * bj + 4, v1); }
                    }
                }
            }
        return st == 0;
    }
};
DI void phase_projab8(const Params& p, int l, LAS char* lds) {
    const int tid = opaque_tid(); char* R = p.ws + O_R;
    constexpr int Kb = F8_P5 ? 256 : 512;
    PairSched S; S.init(F8_P5 ? O_OA8 : O_R + R_OA, O_WPA + (size_t)l * D * Kb * 2, NT, D, Kb);
    S.A1 = (unsigned)(F8_P5 ? O_OB8 : O_R + R_OB); S.B1 = (unsigned)(O_WPB + (size_t)l * D * Kb * 2);
    EpiMerge E{(const unsigned char*)(R + R_MA), (const unsigned char*)(R + R_MB), (bf16_t*)(R + R_MERGED), (unsigned char*)(p.ws + O_MG8), (F8_P6 ? MS8 : 1.0f) / (F8_P5 ? OS8 * WS8 : 1.0f)};
    gemm8<F8_P5>(lds, p.ws, Kb, S, E, tid);
}
struct EpiWout {
    const bf16_t* xin; bf16_t* Y; float ds;
    DI bool operator()(f32x4 (&acc)[2][2][4][2], const GUnit& u, int wr, int wc, int fr, int fq) const {
#pragma unroll
        for (int ai = 0; ai < 2; ++ai)
#pragma unroll
            for (int m = 0; m < 4; ++m) {
                const size_t o = (size_t)(u.pm * 256 + 128 * ai + 64 * wr + 16 * m + fr) * D + u.pn * 256 + 32 * wc + 8 * fq;
#pragma unroll
                for (int bj = 0; bj < 2; ++bj)
#pragma unroll
                    for (int n = 0; n < 2; ++n) { const s16x4 xb = *(const s16x4*)(xin + o + 128 * bj + 4 * n); f32x4 v;
#pragma unroll
                        for (int q = 0; q < 4; ++q) v[q] = bf2f((unsigned short)xb[q]) * ALPHA + acc[ai][bj][m][n][q] * ds;
                        st_bf16x4e(Y + o + 128 * bj + 4 * n, v); }
            }
        return false;
    }
};
DI void phase_wout8(const Params& p, int l, LAS char* lds) {
    const int tid = opaque_tid(); char* R = p.ws + O_R;
    constexpr int Kb = F8_P6 ? D / 2 : D;
    DenseSched S; S.init(F8_P6 ? O_MG8 : O_R + R_MERGED, O_WOUT + (size_t)l * D * Kb * 2, NT, D, Kb);
    EpiWout E{(const bf16_t*)(p.ws + (l == 0 ? O_XB0 : O_XB1)), (bf16_t*)(R + R_YPRE), F8_P6 ? 1.0f / (MS8 * WS8) : 1.0f};
    gemm8<F8_P6>(lds, p.ws, Kb, S, E, tid);
}
struct EpiLogit {
    float* LG;
    DI bool operator()(f32x4 (&acc)[2][2][4][2], const GUnit& u, int wr, int wc, int fr, int fq) const {
#pragma unroll
        for (int ai = 0; ai < 2; ++ai)
#pragma unroll
            for (int m = 0; m < 4; ++m) {
                const size_t o = (size_t)(u.pm * 256 + 128 * ai + 64 * wr + 16 * m + fr) * NE + 32 * wc + 8 * fq;
#pragma unroll
                for (int bj = 0; bj < 2; ++bj)
#pragma unroll
                    for (int n = 0; n < 2; ++n) st_f32x4e(LG + o + 128 * bj + 4 * n, acc[ai][bj][m][n]);
            }
        return false;
    }
};
DI void phase_router8(const Params& p, int l, LAS char* lds) {
    const int tid = opaque_tid();
    DenseSched S; S.init(O_XB1, O_WR + (size_t)l * NE * D * 2, NT, NE, D);
    EpiLogit E{(float*)(p.ws + O_LOGIT)};
    gemm8<false>(lds, p.ws, D, S, E, tid);
}
struct EpiSwiglu {
    bf16_t* H; float ds;
    DI bool operator()(f32x4 (&acc)[2][2][4][2], const GUnit& u, int wr, int wc, int fr, int fq) const {
#pragma unroll
        for (int ai = 0; ai < 2; ++ai) if (ai < u.x1) {
#pragma unroll
            for (int m = 0; m < 4; ++m) {
                bf16_t* hr = H + (size_t)(u.x0 + 128 * ai + 64 * wr + 16 * m + fr) * DE + u.pn * 128 + 32 * wc + 8 * fq;
                f32x4 hv[2];
#pragma unroll
                for (int n = 0; n < 2; ++n) { const f32x4 gv = acc[ai][0][m][n] * ds, uv = acc[ai][1][m][n] * ds;
#pragma unroll
                    for (int q = 0; q < 4; ++q) hv[n][q] = gv[q] * frcp(1.0f + __expf(-gv[q])) * uv[q]; }
                if (F8_M2) { u32x2 w8; w8.x = pk4_fp8(hv[0][0] * HS8, hv[0][1] * HS8, hv[0][2] * HS8, hv[0][3] * HS8); w8.y = pk4_fp8(hv[1][0] * HS8, hv[1][1] * HS8, hv[1][2] * HS8, hv[1][3] * HS8);
                    *(u32x2*)((unsigned char*)H + (size_t)(u.x0 + 128 * ai + 64 * wr + 16 * m + fr) * DE + u.pn * 128 + 32 * wc + 8 * fq) = w8; }
                else { st_bf16x4e(hr, hv[0]); st_bf16x4e(hr + 4, hv[1]); }
            }
        }
        return false;
    }
};
struct EpiDown {
    unsigned char* Y; int var; float ds;
    DI bool operator()(f32x4 (&acc)[2][2][4][2], const GUnit& u, int wr, int wc, int fr, int fq) const {
#pragma unroll
        for (int ai = 0; ai < 2; ++ai) if (ai < u.x1) {
#pragma unroll
            for (int mp = 0; mp < 2; ++mp) {
                unsigned char* yr = Y + (size_t)(u.x0 + 128 * ai + 64 * wr + 16 * (2 * mp + (fq & 1)) + fr) * D + u.pn * 256 + 32 * wc + 16 * (fq >> 1);
#pragma unroll
                for (int bj = 0; bj < 2; ++bj) {
                    u32x2 w[2];
#pragma unroll
                    for (int k = 0; k < 2; ++k) { const f32x4 v0 = acc[ai][bj][2 * mp + k][0] * ds, v1 = acc[ai][bj][2 * mp + k][1] * ds;
                        w[k].x = pk4_fp8(v0[0], v0[1], v0[2], v0[3]); w[k].y = pk4_fp8(v1[0], v1[1], v1[2], v1[3]); }
                    const u32x4 o = widen16(w[0], w[1]);
                    if (var == 2) { const int wv_ = wr * 4 + wc, ii = (ai * 2 + mp) * 2 + bj; *(u32x4*)(Y + (size_t)u.x0 * D + u.pn * 65536 + wv_ * 8192 + ii * 1024 + (fq * 16 + fr) * 16) = o; }
                    else if (var != 1) *(u32x4*)(yr + 128 * bj) = o; else asm volatile("" :: "v"(o));
                }
            }
        }
        return false;
    }
};
DI void phase_moe1_8(const Params& p, int l, LAS char* lds) {
    const int tid = opaque_tid();
    constexpr int Kb = F8_M1 ? D / 2 : D;
    MoeSched S; S.X = (unsigned)(F8_M1 ? O_XA8 : O_XB1); S.Wr = (unsigned)(O_WGU + (size_t)l * NE * 512 * D); S.Ws = (unsigned)(O_WSGU + (size_t)l * 512 * Kb * 2);
    S.TE = (const int*)(p.ws + O_TILEE); S.TR0 = S.TE + 1408; S.TNH = S.TE + 2816; S.RT = (const int*)(p.ws + O_ROWTOK);
    S.ntr = ((const int*)(p.ws + O_MISC))[l]; S.ncol = 2; S.nunits = (S.ntr + 128) * 2; S.G = gridDim.x; S.c = blockIdx.x; S.K = Kb;
    S.wexp = 512u * Kb * 2u; S.wtile = 256u * Kb * 2u; S.gather = true;
    EpiSwiglu E{(bf16_t*)(p.ws + O_H), F8_M1 ? 1.0f / (XS8 * WS8) : 1.0f};
    gemm8<F8_M1>(lds, p.ws, Kb, S, E, tid);
}
DI void phase_moe2_8(const Params& p, int l, LAS char* lds, int var = 0) {
    const int tid = opaque_tid();
    constexpr int Kb = F8_M2 ? DE / 2 : DE;
    MoeSched S; S.X = (unsigned)O_H; S.Wr = (unsigned)(O_WDN + (size_t)l * NE * D * DE); S.Ws = (unsigned)(O_WSD + (size_t)l * D * Kb * 2);
    S.TE = (const int*)(p.ws + O_TILEE); S.TR0 = S.TE + 1408; S.TNH = S.TE + 2816; S.RT = nullptr;
    S.ntr = ((const int*)(p.ws + O_MISC))[l]; S.ncol = 4; S.nunits = (S.ntr + 128) * 4; S.G = gridDim.x; S.c = blockIdx.x; S.K = Kb;
    S.wexp = (unsigned)D * Kb * 2u; S.wtile = 256u * Kb * 2u; S.gather = false;
    EpiDown E{(unsigned char*)(p.ws + O_R), var, F8_M2 ? 16.0f / (HS8 * WS8) : 16.0f};
    gemm8<F8_M2>(lds, p.ws, Kb, S, E, tid);
}
DI void phase_dispatch8(const Params& p, int l, LAS char* lds) {
    const int tid = opaque_tid();
    LAS int* sc = (LAS int*)lds;
    const unsigned* CNT = (const unsigned*)(p.ws + O_CNT) + l * NE;
    int pad = 0, ntl = 0;
    __syncthreads();
    if (tid < NE) { pad = ((int)CNT[tid] + 127) & ~127; ntl = (pad + 255) >> 8; sc[tid] = pad; sc[256 + tid] = ntl; }
    __syncthreads();
    for (int d = 1; d < NE; d <<= 1) {
        int v = 0, v2 = 0;
        if (tid < NE && tid >= d) { v = sc[tid - d]; v2 = sc[256 + tid - d]; }
        __syncthreads();
        if (tid < NE) { sc[tid] += v; sc[256 + tid] += v2; }
        __syncthreads();
    }
    if (blockIdx.x == 0 && tid < NE) {
        int* TE = (int*)(p.ws + O_TILEE); int* TR0 = TE + 1408; int* TNH = TE + 2816;
        const int pe = sc[tid], ps = pe - pad, te = sc[256 + tid], ts = te - ntl;
        for (int k = 0; k < ntl; ++k) { TE[ts + k] = tid; TR0[ts + k] = ps + 256 * k; TNH[ts + k] = (pe - (ps + 256 * k)) >= 256 ? 2 : 1; }
        if (tid == NE - 1) ((int*)(p.ws + O_MISC))[l] = te;
    }
    const int* TOPI = (const int*)(p.ws + O_TOPI); const int* POS = (const int*)(p.ws + O_POS); int* SLOT = (int*)(p.ws + O_SLOT); int* RT = (int*)(p.ws + O_ROWTOK);
    for (size_t a = (size_t)blockIdx.x * NTHREADS + tid; a < (size_t)NT * TOPK; a += (size_t)gridDim.x * NTHREADS) {
        const int e = TOPI[a]; const int ps = (e > 0) ? sc[e - 1] : 0;
        const int dest = ps + POS[a];
        RT[dest] = (int)(a >> 3); SLOT[a] = dest;
    }
    conv_drain(p, l == 0 ? NQ0 : NQ, lds, (volatile LAS unsigned*)(lds + LDS_BYTES), tid);
}

constexpr int NPH = 14;
typedef const __attribute__((address_space(4))) Params* KParams;
DI Params load_params(KParams pk) { Params p;
#pragma unroll
    for (int i = 0; i < 22; ++i) p.in[i] = pk->in[i];
    p.out = pk->out; p.ws = pk->ws; return p; }
template <int PH> DI void run_phase(KParams pk, int l, LAS char* lds, int var = 0) {
    asm volatile("" : "+s"(pk));
    const Params p = load_params(pk);
    if constexpr (PH == 0) phase_prologue(p, lds);
    if constexpr (PH == 1) phase_proj8(p, l, lds);
    if constexpr (PH == 2) { phase_compress1(p, l, lds); if (blockIdx.x >= 32) { const int tid = opaque_tid(); for (int i = (int)blockIdx.x - 32; i < 16 * (64 - WIN_SPLIT); i += (int)gridDim.x - 32) nsa_win_unit(p, (i & 15) >> 1, i & 1, WIN_SPLIT + (i >> 4), lds, tid); } }
    if constexpr (PH == 3) { phase_compress2(p, l, lds);
#if MOBA_SPARSE
        if (var != 1) { const int tid = opaque_tid(); for (int u = blockIdx.x; u < 1024; u += gridDim.x) if ((u >> 6) > 0) moba_gate_unit(p, l, u & 63, u >> 6, lds, tid); }
#endif
    }
    if constexpr (PH == 4) phase_attention(p, l, lds);
    if constexpr (PH == 14) phase_moba_own(p, lds, var);
    if constexpr (PH == 5) phase_projab8(p, l, lds);
    if constexpr (PH == 6) phase_wout8(p, l, lds);
    if constexpr (PH == 7) phase_ln1(p, l);
    if constexpr (PH == 8) phase_router8(p, l, lds);
    if constexpr (PH == 9) phase_routing(p, l, lds, var);
    if constexpr (PH == 10) phase_dispatch8(p, l, lds);
    if constexpr (PH == 11) phase_moe1_8(p, l, lds);
    if constexpr (PH == 12) phase_moe2_8(p, l, lds, var);
    if constexpr (PH == 13) phase_combine(p, l, var);
}

DI void xcd_barrier_w(const XcdBarrier& b, KParams pk, LAS char* lds) {
    asm volatile("s_waitcnt vmcnt(0)" ::: "memory");
    __syncthreads();
    const int tid = opaque_tid();
    unsigned* bar = b.bar; unsigned bx = 0u, gen = 0u;
    volatile LAS unsigned* st = b.st;
    if (tid == 0) {
        bx = xb_xcc_id();
        __builtin_amdgcn_s_waitcnt(0);
        unsigned nloc = st[0], nx = st[1];
        if (nloc == 0u) { xcd_barrier_complete(bar, bx, nloc, nx); st[0] = nloc; st[1] = nx; }
        const unsigned old = xb_add(&bar[XB_XSUB(bx)], 1u);
        gen = old / nloc;
        if (old + 1u == (gen + 1u) * nloc) {
            __builtin_amdgcn_fence(__ATOMIC_RELEASE, "agent");
            asm volatile("s_waitcnt vmcnt(0)" ::: "memory");
            const unsigned og = xb_add(&bar[XB_TOP], 1u);
            const unsigned tg = og / nx;
            if (og + 1u == (tg + 1u) * nx) xb_add(&bar[XB_TOPGEN], 1u);
            else XB_SPIN(xb_ld(&bar[XB_TOPGEN]) == tg, bar);
            __builtin_amdgcn_fence(__ATOMIC_ACQUIRE, "agent");
            xb_add(&bar[XB_XGEN(bx)], 1u);
            asm volatile("s_waitcnt vmcnt(0)" ::: "memory");
            st[2] = 1u;
        } else st[2] = 0u;
    }
    __syncthreads();
    for (;;) {
        if (st[2]) break;
        if (tid == 0) {
            if (xb_ld(&bar[XB_XGEN(bx)]) != gen) { __builtin_amdgcn_fence(__ATOMIC_ACQUIRE, "agent"); asm volatile("s_waitcnt vmcnt(0)" ::: "memory"); st[2] = 1u; }
            else if (st[3] != 0xffffffffu) { const unsigned q = atomicAdd((unsigned*)(pk->ws + O_WQ), 1u); st[3] = q < (unsigned)NQ ? q : 0xffffffffu; }
            else { XB_SPIN(xb_ld(&bar[XB_XGEN(bx)]) == gen, bar); __builtin_amdgcn_fence(__ATOMIC_ACQUIRE, "agent"); asm volatile("s_waitcnt vmcnt(0)" ::: "memory"); st[2] = 1u; }
        }
        __syncthreads();
        if (st[2]) break;
        const unsigned q = st[3];
        __syncthreads();
        if (q != 0xffffffffu) { const Params p = load_params(pk); conv_pair(p, (int)q, lds, tid); }
    }
    __syncthreads();
}

extern __shared__ __attribute__((aligned(16))) char dyn_smem[];

#if MK_MULTI
template <int PH> __global__ void __launch_bounds__(NTHREADS, 2) k_phase(Params p, int l) {
    (void)p; run_phase<PH>((KParams)__builtin_amdgcn_kernarg_segment_ptr(), l, (LAS char*)dyn_smem);
}

#else
__global__ void __launch_bounds__(NTHREADS, 2) k_mega(Params p) {
    LAS char* lds = (LAS char*)dyn_smem;
    LAS char* xbw = lds + LDS_BYTES;
    if (opaque_tid() == 0) *(LAS u32x4*)xbw = (u32x4){0u, 0u, 0u, 0u};
    __syncthreads();
    KParams pk = (KParams)__builtin_amdgcn_kernarg_segment_ptr();
    XcdBarrier bar = xcd_barrier_post((unsigned*)(pk->ws + O_BAR), (volatile LAS unsigned*)xbw);
#define RUNP(PH) do { run_phase<PH>(pk, l, lds); if (PROBE_DUP == PH || (PROBE_DUP == 201 && (PH == 2 || PH == 3)) || (PROBE_DUP == 202 && (PH == 5 || PH == 6)) || (PROBE_DUP == 203 && (PH == 7 || PH == 8 || PH == 10)) || (PROBE_DUP == 204 && PH == 13)) { for (int rep = 0; rep < NREP; ++rep) { xcd_barrier(bar); run_phase<PH>(pk, l, lds, PROBE_VAR); } } } while (0)
    { const int l = 0; run_phase<0>(pk, l, lds); if (PROBE_DUP == 100) { for (int rep = 0; rep < NREP; ++rep) { xcd_barrier(bar); run_phase<0>(pk, l, lds); } } }
    xcd_barrier_w(bar, pk, lds);
#define LAYER(LL, LASTL) do { const int l = LL; \
        RUNP(1); xcd_barrier_w(bar, pk, lds); \
        RUNP(2); xcd_barrier_w(bar, pk, lds); \
        RUNP(3); xcd_barrier_w(bar, pk, lds); \
        RUNP(4); \
        if (PROBE_DUP == 41) { for (int rep = 0; rep < NREP; ++rep) { xcd_barrier(bar); const Params pq = load_params(pk); phase_attention(pq, l, lds, 1); } } \
        if (PROBE_DUP == 42) { for (int rep = 0; rep < NREP; ++rep) { xcd_barrier(bar); const Params pq = load_params(pk); phase_attention(pq, l, lds, 2); } } \
        if (PROBE_DUP == 400) { for (int rep = 0; rep < NREP; ++rep) { xcd_barrier(bar); run_phase<2>(pk, l, lds); xcd_barrier(bar); const Params pq = load_params(pk); phase_attention(pq, l, lds, 1); } } \
        xcd_barrier_w(bar, pk, lds); \
        if (MOBA_SPARSE && PROBE_DUP == 140) { for (int rep = 0; rep < NREP; ++rep) { run_phase<14>(pk, l, lds, PROBE_VAR); xcd_barrier(bar); } } \
        if (MOBA_SPARSE) { RUNP(14); xcd_barrier_w(bar, pk, lds); } \
        RUNP(5); xcd_barrier_w(bar, pk, lds); \
        RUNP(6); xcd_barrier_w(bar, pk, lds); \
        RUNP(7); xcd_barrier_w(bar, pk, lds); \
        if (PROBE_DUP == 300) { for (int rep = 0; rep < 2 * NREP; ++rep) xcd_barrier(bar); } \
        RUNP(8); xcd_barrier_w(bar, pk, lds); \
        run_phase<9>(pk, l, lds); if (PROBE_DUP == 9) { for (int rep = 0; rep < NREP; ++rep) { xcd_barrier(bar); run_phase<9>(pk, l, lds, 1); } } xcd_barrier_w(bar, pk, lds); \
        RUNP(10); xcd_barrier_w(bar, pk, lds); \
        RUNP(11); xcd_barrier_w(bar, pk, lds); \
        if (PROBE_DUP == 120) { for (int rep = 0; rep < NREP; ++rep) { run_phase<12>(pk, l, lds, 2); xcd_barrier(bar); } } \
        RUNP(12); xcd_barrier_w(bar, pk, lds); \
        RUNP(13); \
        if (!(LASTL)) xcd_barrier_w(bar, pk, lds); } while (0)
    LAYER(0, false);
    LAYER(1, true);
}
#endif
#if MK_MULTI
template <int PH> static void launch_phase(const Params& p, int l, int grid, hipStream_t stream) {
    static bool attr = false;
    if (!attr) { (void)hipFuncSetAttribute((const void*)k_phase<PH>, hipFuncAttributeMaxDynamicSharedMemorySize, LDS_BYTES + 16); attr = true; }
    hipLaunchKernelGGL(k_phase<PH>, dim3(grid), dim3(NTHREADS), LDS_BYTES + 16, stream, p, l);
}

#endif
extern "C" void kernel_launch(void* const* d_in, const int* in_sizes, int n_in, void* d_out, int out_size, void* d_ws, size_t ws_size, hipStream_t stream) {
    (void)in_sizes; (void)n_in; (void)out_size; (void)ws_size;
    Params p{};
    for (int i = 0; i < 22; ++i) p.in[i] = (const float*)d_in[i];
    p.out = (float*)d_out; p.ws = (char*)d_ws;
    static int grid = 0;
    if (!grid) {
        int dev = 0, cus = 0; (void)hipGetDevice(&dev); (void)hipDeviceGetAttribute(&cus, hipDeviceAttributeMultiprocessorCount, dev);
        if (cus <= 0) cus = 256;
        grid = cus;
    }
    (void)hipMemsetAsync(d_ws, 0, ZERO_BYTES, stream);
#if MK_MULTI
    launch_phase<0>(p, 0, grid, stream);
    for (int l = 0; l < NL; ++l) {
        launch_phase<1>(p, l, grid, stream); launch_phase<2>(p, l, grid, stream); launch_phase<3>(p, l, grid, stream); launch_phase<4>(p, l, grid, stream);
        launch_phase<5>(p, l, grid, stream); launch_phase<6>(p, l, grid, stream); launch_phase<7>(p, l, grid, stream); launch_phase<8>(p, l, grid, stream);
        launch_phase<9>(p, l, grid, stream); launch_phase<10>(p, l, grid, stream); launch_phase<11>(p, l, grid, stream); launch_phase<12>(p, l, grid, stream);
        launch_phase<13>(p, l, grid, stream);
    }
#else
    static bool attr = false;
    if (!attr) {
        (void)hipFuncSetAttribute((const void*)k_mega, hipFuncAttributeMaxDynamicSharedMemorySize, LDS_BYTES + 16);
        int per_cu = 0; (void)hipOccupancyMaxActiveBlocksPerMultiprocessor(&per_cu, (const void*)k_mega, NTHREADS, LDS_BYTES + 16);
        if (per_cu < 1) fprintf(stderr, "k_mega: occupancy query says %d blocks per CU\n", per_cu);
        attr = true;
    }
    hipLaunchKernelGGL(k_mega, dim3(grid), dim3(NTHREADS), LDS_BYTES + 16, stream, p);
#endif
}
```

```cpp
#include <hip/hip_runtime.h>
#include <stdint.h>
#include <stdio.h>

#ifndef PROBE_DUP
#define PROBE_DUP 0
#define NREP 10
#define PROBE_VAR 0
#endif
#ifndef MK_MULTI
#define MK_MULTI 0
#endif

#define DI __device__ __forceinline__
#define LAS __attribute__((address_space(3)))

typedef unsigned short bf16_t;
typedef short bf16x8 __attribute__((ext_vector_type(8)));
typedef short s16x4 __attribute__((ext_vector_type(4)));
typedef __bf16 bf16x2n __attribute__((ext_vector_type(2)));
typedef float f32x2 __attribute__((ext_vector_type(2)));
typedef float f32x4 __attribute__((ext_vector_type(4)));
typedef float f32x16 __attribute__((ext_vector_type(16)));
typedef unsigned u32x4 __attribute__((ext_vector_type(4)));
typedef unsigned u32x2 __attribute__((ext_vector_type(2)));

constexpr int D = 1024, NBATCH = 8, SEQ = 4096, NT = NBATCH * SEQ, NL = 2;
constexpr int IN_COLS = 4888, NP = 5120;
constexpr int NE = 256, DE = 256, TOPK = 8;
constexpr int MAXROWS = NT * TOPK + NE * 128;
constexpr int TOTROWS = MAXROWS + NT;
constexpr float ALPHA = 1.41421356237309515f;
constexpr float LN_EPS = 1e-5f;
constexpr float SM_C = 0.125f * 1.44269504088896341f;
constexpr float NEGF = -1e30f, BIGF = 1e30f;

enum { I_X = 0, I_WIN, I_BIN, I_CPOS, I_CW1, I_CB1, I_CW2, I_WPA, I_WPB, I_WOUT, I_LN1G, I_LN1B, I_RW, I_RB, I_WG, I_WU, I_WD, I_SG, I_SU, I_SD, I_LN2G, I_LN2B };

struct Params { const float* in[22]; float* out; char* ws; };

constexpr size_t al256(size_t x) { return (x + 255) & ~(size_t)255; }
constexpr size_t O_BAR = 0;
constexpr size_t O_CNT = 16384;
constexpr size_t O_MISC = 20480;
constexpr size_t ZERO_BYTES = 32768;
constexpr size_t O_COS = 32768;
constexpr size_t O_SIN = O_COS + (size_t)SEQ * 32 * 4;
constexpr size_t O_BIASP = O_SIN + (size_t)SEQ * 32 * 4;
constexpr size_t O_C1 = O_BIASP + al256((size_t)NL * NP * 4);
constexpr size_t O_C1PART = O_C1 + al256((size_t)NL * 2 * 128 * 4);
constexpr size_t O_WIN = O_C1PART + (size_t)NL * 2 * 64 * 128 * 4;
constexpr size_t O_WPA = O_WIN + (size_t)NL * NP * D * 2;
constexpr size_t O_WPB = O_WPA + (size_t)NL * D * 512 * 2;
constexpr size_t O_WOUT = O_WPB + (size_t)NL * D * 512 * 2;
constexpr size_t O_WR = O_WOUT + (size_t)NL * D * D * 2;
constexpr size_t O_W1 = O_WR + (size_t)NL * NE * D * 2;
constexpr size_t O_W2 = O_W1 + (size_t)NL * 2 * 128 * 2048 * 2;
constexpr size_t O_WSGU = O_W2 + (size_t)NL * 2 * 128 * 128 * 2;
constexpr size_t O_WSD = O_WSGU + (size_t)NL * 512 * D * 2;
constexpr size_t O_WGU = O_WSD + (size_t)NL * D * DE * 2;
constexpr size_t O_WDN = O_WGU + (size_t)NE * 512 * D * 2;
constexpr size_t O_XB0 = O_WDN + (size_t)NE * D * DE * 2;
constexpr size_t O_XB1 = O_XB0 + (size_t)NT * D * 2;
constexpr size_t O_XF1 = O_XB1 + (size_t)NT * D * 2;
constexpr size_t O_XF2 = O_XF1 + (size_t)NT * D * 4;
constexpr size_t O_LOGIT = O_XF2 + (size_t)NT * D * 4;
#ifndef F8_P1
#define F8_P1 1
#define F8_P5 1
#define F8_P6 1
#define F8_M1 1
#define F8_M2 1
#endif
constexpr size_t O_XA8 = O_XF1;
constexpr size_t O_OA8 = O_XF2;
constexpr size_t O_OB8 = O_OA8 + (size_t)NT * 512;
constexpr size_t O_MG8 = O_OB8 + (size_t)NT * 512;
constexpr float XS8 = 4.f, WS8 = 64.f, OS8 = 32.f, MS8 = 64.f, HS8 = 8.f;
constexpr size_t O_TOPI = O_LOGIT + (size_t)NT * NE * 4;
constexpr size_t O_GATE = O_TOPI + (size_t)NT * TOPK * 4;
constexpr size_t O_POS = O_GATE + (size_t)NT * TOPK * 4;
constexpr size_t O_SLOT = O_POS + (size_t)NT * TOPK * 4;
constexpr size_t O_ROWTOK = O_SLOT + (size_t)NT * TOPK * 4;
constexpr size_t O_TILEE = O_ROWTOK + al256((size_t)(MAXROWS + 256) * 4);
constexpr size_t O_H = O_TILEE + al256((size_t)3 * 1408 * 4);
constexpr size_t O_R = O_H + (size_t)TOTROWS * DE * 2;
constexpr size_t R_QA = 0;
constexpr size_t R_QAR = R_QA + (size_t)NT * 512 * 2;
constexpr size_t R_KC = R_QAR + (size_t)NT * 512 * 2;
constexpr size_t R_VC = R_KC + (size_t)NT * 128 * 2 + 4096;
constexpr size_t R_KS = R_VC + (size_t)NT * 128 * 2 + 4096;
constexpr size_t R_VS = R_KS + (size_t)NT * 128 * 2;
constexpr size_t R_KW = R_VS + (size_t)NT * 128 * 2;
constexpr size_t R_VW = R_KW + (size_t)NT * 128 * 2;
constexpr size_t R_QB = R_VW + (size_t)NT * 128 * 2;
constexpr size_t R_KB = R_QB + (size_t)NT * 512 * 2;
constexpr size_t R_VB = R_KB + (size_t)NT * 512 * 2;
constexpr size_t R_MA = R_VB + (size_t)NT * 512 * 2;
constexpr size_t R_MB = R_MA + (size_t)NT * D * 2;
constexpr size_t R_GA = R_MB + (size_t)NT * D * 2;
constexpr size_t R_OA = R_GA + (size_t)NT * 24 * 4;
constexpr size_t R_OB = R_OA + (size_t)NT * 512 * 2;
constexpr size_t R_MERGED = R_OB + (size_t)NT * 512 * 2;
constexpr size_t R_YPRE = R_MERGED + (size_t)NT * D * 2;
constexpr size_t R_HID = R_YPRE + (size_t)NT * D * 4;
constexpr size_t R_KCC = R_HID + (size_t)2 * 16 * 256 * 128 * 2;
constexpr size_t R_VCC = R_KCC + (size_t)16 * 256 * 64 * 2;
constexpr size_t R_KMEAN = R_VCC + (size_t)16 * 256 * 64 * 2;
constexpr size_t R_MIXEND = R_KMEAN + (size_t)64 * 16 * 64 * 4;
constexpr size_t R_YROWS_BYTES = (size_t)TOTROWS * D;
constexpr size_t R_BYTES = R_MIXEND > R_YROWS_BYTES ? R_MIXEND : R_YROWS_BYTES;
constexpr size_t WS_NEED = O_R + R_BYTES;
static_assert(WS_NEED < (size_t)1780 * 1000 * 1000, "workspace too large");

constexpr int LDS_BYTES = 128 * 1024;
constexpr int NTHREADS = 512;

DI int opaque_tid() { int t = threadIdx.x; asm volatile("" : "+v"(t)); return t; }
DI unsigned pk2(float lo, float hi) { f32x2 a = {lo, hi}; return __builtin_bit_cast(unsigned, __builtin_convertvector(a, bf16x2n)); }
DI float bf2f(unsigned short v) { return __uint_as_float(((unsigned)v) << 16); }
DI float fexp2(float x) { return __builtin_amdgcn_exp2f(x); }
DI float frcp(float x) { return __builtin_amdgcn_rcpf(x); }
DI float sigmoidf_(float x) { return frcp(1.0f + __expf(-x)); }
DI float shx(float v, int m) { return __shfl_xor(v, m); }
DI float max3f(float a, float b, float c) { float r; asm("v_max3_f32 %0, %1, %2, %3" : "=v"(r) : "v"(a), "v"(b), "v"(c)); return r; }
DI f32x16 mfma32(bf16x8 a, bf16x8 b, f32x16 c) { return __builtin_amdgcn_mfma_f32_32x32x16_bf16(a, b, c, 0, 0, 0); }
DI f32x4 mfma16(bf16x8 a, bf16x8 b, f32x4 c) { return __builtin_amdgcn_mfma_f32_16x16x32_bf16(a, b, c, 0, 0, 0); }
typedef int i32x4 __attribute__((ext_vector_type(4)));
typedef int i32x8 __attribute__((ext_vector_type(8)));
DI float clamp8(float v) { return __builtin_amdgcn_fmed3f(v, -448.f, 448.f); }
DI unsigned pk4_fp8(float a, float b, float c, float d) { int w = 0; w = __builtin_amdgcn_cvt_pk_fp8_f32(clamp8(a), clamp8(b), w, false); w = __builtin_amdgcn_cvt_pk_fp8_f32(clamp8(c), clamp8(d), w, true); return (unsigned)w; }
DI u32x4 widen16(u32x2 a, u32x2 b) {
    const auto r0 = __builtin_amdgcn_permlane16_swap(a.x, b.x, false, false);
    const auto r1 = __builtin_amdgcn_permlane16_swap(a.y, b.y, false, false);
    u32x4 o; o.x = r0[0]; o.y = r1[0]; o.z = r0[1]; o.w = r1[1]; return o;
}
DI int projmap2(int n) {
    const int tl = n >> 8, w = n & 255;
    if (tl >= 11) { if (tl < 19) return ((w < 128) ? 2840 : 3864) + (tl - 11) * 128 + (w & 127);
        return w < 24 ? 1280 + w : -1; }
    const int hd = (w >> 5) & 3, d = ((w >> 7) << 5) + (w & 31);
    if (tl < 2) return (4 * tl + hd) * 64 + d;
    if (tl < 5) { const int base = 512 + (tl - 2) * 256; return base + hd * 64 + d; }
    const int sec = (tl - 5) >> 1; return 1304 + sec * 512 + (4 * ((tl - 5) & 1) + hd) * 64 + d;
}
DI int projmap(int n) { return n < 1280 ? n : (n < 4864 ? n + 24 : (n < 4888 ? n - 4864 + 1280 : -1)); }

#define XB_TMO      128
#define XB_XCNT(j)  (256  + 64 * (j))
#define XB_XSUB(j)  (1280 + 64 * (j))
#define XB_XGEN(j)  (2304 + 64 * (j))
#define XB_TOP      3328
#define XB_TOPGEN   3392
#define XCD_BAR_WORDS 3456
#define XB_SPIN_CAP (1u << 22)
DI unsigned xb_ld(unsigned* p)              { return __hip_atomic_load(p, __ATOMIC_RELAXED, __HIP_MEMORY_SCOPE_AGENT); }
DI unsigned xb_add(unsigned* p, unsigned v) { return __hip_atomic_fetch_add(p, v, __ATOMIC_RELAXED, __HIP_MEMORY_SCOPE_AGENT); }
DI unsigned xb_xcc_id() { return (unsigned)__builtin_amdgcn_s_getreg((3 << 11) | 20) & 0xFu; }
#define XB_SPIN(cond, bar) do { unsigned _sp = 0; while (cond) { __builtin_amdgcn_s_sleep(1); \
    if ((++_sp & 255u) == 0u) { if (xb_ld(&(bar)[XB_TMO])) break; if (_sp > XB_SPIN_CAP) { atomicAdd(&(bar)[XB_TMO], 1u); break; } } } } while (0)
struct XcdBarrier { unsigned* bar; unsigned x; volatile LAS unsigned* st; };
DI XcdBarrier xcd_barrier_post(unsigned* bar, volatile LAS unsigned* st) {
    XcdBarrier b; b.bar = bar; b.x = xb_xcc_id(); b.st = st;
    if (opaque_tid() == 0) (void)xb_add(&bar[XB_XCNT(b.x)], 1u);
    return b;
}
DI void xcd_barrier_complete(unsigned* bar, unsigned x, unsigned& nloc, unsigned& nx) {
    const unsigned G = gridDim.x * gridDim.y * gridDim.z;
    unsigned sum, cnt, mine, sp = 0u;
    for (;;) {
        sum = 0u; cnt = 0u; mine = 0u;
#pragma unroll
        for (unsigned j = 0; j < 16; ++j) { const unsigned c = xb_ld(&bar[XB_XCNT(j)]); sum += c; cnt += (c > 0u) ? 1u : 0u; mine = (j == x) ? c : mine; }
        if (sum == G) break;
        __builtin_amdgcn_s_sleep(1);
        if ((++sp & 255u) == 0u) { if (xb_ld(&bar[XB_TMO])) break; if (sp > XB_SPIN_CAP) { atomicAdd(&bar[XB_TMO], 1u); break; } }
    }
    nloc = mine > 0u ? mine : 1u; nx = cnt > 0u ? cnt : 1u;
}
DI void xcd_barrier(const XcdBarrier& b) {
    asm volatile("s_waitcnt vmcnt(0)" ::: "memory");
    __syncthreads();
    if (opaque_tid() == 0) {
        unsigned* bar = b.bar; const unsigned bx = xb_xcc_id();
        __builtin_amdgcn_s_waitcnt(0);
        unsigned nloc = b.st[0], nx = b.st[1];
        if (nloc == 0u) { xcd_barrier_complete(bar, bx, nloc, nx); b.st[0] = nloc; b.st[1] = nx; }
        const unsigned old = xb_add(&bar[XB_XSUB(bx)], 1u);
        const unsigned gen = old / nloc;
        if (old + 1u == (gen + 1u) * nloc) {
            __builtin_amdgcn_fence(__ATOMIC_RELEASE, "agent");
            asm volatile("s_waitcnt vmcnt(0)" ::: "memory");
            const unsigned og = xb_add(&bar[XB_TOP], 1u);
            const unsigned tg = og / nx;
            if (og + 1u == (tg + 1u) * nx) xb_add(&bar[XB_TOPGEN], 1u);
            else XB_SPIN(xb_ld(&bar[XB_TOPGEN]) == tg, bar);
            __builtin_amdgcn_fence(__ATOMIC_ACQUIRE, "agent");
            xb_add(&bar[XB_XGEN(bx)], 1u);
            asm volatile("s_waitcnt vmcnt(0)" ::: "memory");
        } else {
            XB_SPIN(xb_ld(&bar[XB_XGEN(bx)]) == gen, bar);
            __builtin_amdgcn_fence(__ATOMIC_ACQUIRE, "agent");
            asm volatile("s_waitcnt vmcnt(0)" ::: "memory");
        }
    }
    __syncthreads();
}

DI void stage_rc(int b, int& R, int& C) { const int st = b >> 10, sb = b & 1023, swz = sb ^ (((sb >> 9) & 1) << 5); R = (st >> 1) * 16 + (swz >> 6); C = (st & 1) * 32 + ((swz & 63) >> 1); }

template <int WM, int WN>
DI void gemm_kloop(f32x4 (&acc)[4][4], const bf16_t* (&ap)[WM], const bf16_t* (&bp)[WN], int nkt, LAS char* lds, int tid) {
    constexpr int AB = WM * 8192, BB = WN * 8192, ST = AB + BB;
    const int lane = tid & 63, wid = tid >> 6, wm = wid / WN, wn = wid % WN, fr = lane & 15, fq = lane >> 4;
    const int loff = (fr * 64 + fq * 16) ^ ((fr >> 3) << 5);
    u32x4 ra[WM], rb[WN];
#pragma unroll
    for (int i = 0; i < WM; ++i) ra[i] = *(const u32x4*)(ap[i]);
#pragma unroll
    for (int i = 0; i < WN; ++i) rb[i] = *(const u32x4*)(bp[i]);
#pragma unroll
    for (int i = 0; i < WM; ++i) *(LAS u32x4*)(lds + tid * 16 + 8192 * i) = ra[i];
#pragma unroll
    for (int i = 0; i < WN; ++i) *(LAS u32x4*)(lds + AB + tid * 16 + 8192 * i) = rb[i];
    __syncthreads();
    for (int kt = 0; kt < nkt; ++kt) {
        LAS char* cur = lds + (kt & 1) * ST;
        LAS char* nxt = lds + ((kt + 1) & 1) * ST;
        const bool more = kt + 1 < nkt;
        if (more) {
#pragma unroll
            for (int i = 0; i < WM; ++i) ra[i] = *(const u32x4*)(ap[i] + (size_t)(kt + 1) * 64);
#pragma unroll
            for (int i = 0; i < WN; ++i) rb[i] = *(const u32x4*)(bp[i] + (size_t)(kt + 1) * 64);
        }
#pragma unroll
        for (int kh = 0; kh < 2; ++kh) {
            bf16x8 af[4], bg[4];
#pragma unroll
            for (int m = 0; m < 4; ++m) af[m] = *(LAS const bf16x8*)(cur + (2 * (4 * wm + m) + kh) * 1024 + loff);
#pragma unroll
            for (int n = 0; n < 4; ++n) bg[n] = *(LAS const bf16x8*)(cur + AB + (2 * (4 * wn + n) + kh) * 1024 + loff);
#pragma unroll
            for (int m = 0; m < 4; ++m)
#pragma unroll
                for (int n = 0; n < 4; ++n) acc[m][n] = mfma16(bg[n], af[m], acc[m][n]);
        }
        if (more) {
#pragma unroll
            for (int i = 0; i < WM; ++i) *(LAS u32x4*)(nxt + tid * 16 + 8192 * i) = ra[i];
#pragma unroll
            for (int i = 0; i < WN; ++i) *(LAS u32x4*)(nxt + AB + tid * 16 + 8192 * i) = rb[i];
        }
        __syncthreads();
    }
}
DI void zero_acc(f32x4 (&acc)[4][4]) {
#pragma unroll
    for (int m = 0; m < 4; ++m)
#pragma unroll
        for (int n = 0; n < 4; ++n) acc[m][n] = (f32x4){0.f, 0.f, 0.f, 0.f};
}
DI void st_bf16x4(bf16_t* p, f32x4 v) { u32x2 w; w.x = pk2(v[0], v[1]); w.y = pk2(v[2], v[3]); *(u32x2*)p = w; }
#ifndef EPI_NT
#define EPI_NT 0
#endif
DI void st_bf16x4e(bf16_t* p, f32x4 v) { u32x2 w; w.x = pk2(v[0], v[1]); w.y = pk2(v[2], v[3]); if (EPI_NT) __builtin_nontemporal_store(w, (u32x2*)p); else *(u32x2*)p = w; }
DI void st_f32x4e(float* p, f32x4 v) { if (EPI_NT) __builtin_nontemporal_store(v, (f32x4*)p); else *(f32x4*)p = v; }

struct TrJob { const float* s0; const float* s1; int src_ld; int nsrc; bf16_t* dst; int K; int mode; };
DI void tr_tiles4x(const float* js0, const float* js1, int jsrc_ld, int jnsrc, bf16_t* jdst, int jK, int jmode, int k0, int n0, LAS char* lds, int tid) {
    LAS float* T = (LAS float*)lds;
#pragma unroll
    for (int q = 0; q < 4; ++q) {
        const int nn = tid & 63, n = n0 + q * 64 + nn;
        const float* sp; int col;
        if (jmode == 2) { const int tl = n >> 8, w = n & 255; sp = (w < 128) ? js0 : js1; col = tl * 128 + (w & 127); }
        else if (jmode == 1) { sp = js0; col = projmap2(n); }
        else { sp = js0; col = (n < jnsrc) ? n : -1; }
#pragma unroll
        for (int i = 0; i < 8; ++i) {
            const int kk = (tid >> 6) + 8 * i;
            const float v = (col >= 0) ? sp[(size_t)(k0 + kk) * jsrc_ld + col] : 0.f;
            T[(q * 64 + kk) * 65 + nn] = v;
        }
    }
    __syncthreads();
#pragma unroll
    for (int q = 0; q < 4; ++q) {
        const int nn = tid >> 3, kc = tid & 7;
        float v[8];
#pragma unroll
        for (int i = 0; i < 8; ++i) v[i] = T[(q * 64 + kc * 8 + i) * 65 + nn];
        u32x4 w; w.x = pk2(v[0], v[1]); w.y = pk2(v[2], v[3]); w.z = pk2(v[4], v[5]); w.w = pk2(v[6], v[7]);
        *(u32x4*)(jdst + (size_t)(n0 + q * 64 + nn) * jK + k0 + kc * 8) = w;
    }
    __syncthreads();
}
DI void tr_tiles4(const TrJob& j, int k0, int n0, LAS char* lds, int tid) { tr_tiles4x(j.s0, j.s1, j.src_ld, j.nsrc, j.dst, j.K, j.mode, k0, n0, lds, tid); }
DI void tr_job_run(const TrJob& j, int Nd, int first, int stride, LAS char* lds, int tid) {
    const int ng = Nd / 256, nk = j.K / 64;
    for (int u = first; u < ng * nk; u += stride) { const int gk = u % nk, gn = u / nk; tr_tiles4(j, gk * 64, gn * 256, lds, tid); }
}
DI void moe_weight_convert(const Params& p, int l, LAS char* lds, int tid) {
    const float* wg = p.in[I_WG] + (size_t)l * NE * D * DE; const float* wu = p.in[I_WU] + (size_t)l * NE * D * DE; const float* wd = p.in[I_WD] + (size_t)l * NE * DE * D;
    bf16_t* WGU = (bf16_t*)(p.ws + O_WGU); bf16_t* WDN = (bf16_t*)(p.ws + O_WDN);
    for (int u = blockIdx.x; u < NE * 48; u += gridDim.x) {
        const int e = u / 48, it = u % 48;
        if (it < 32) tr_tiles4x(wg + (size_t)e * D * DE, wu + (size_t)e * D * DE, DE, DE, WGU + (size_t)e * 512 * D, D, 2, (it & 15) * 64, (it >> 4) * 256, lds, tid);
        else { const int i2 = it - 32; tr_tiles4x(wd + (size_t)e * DE * D, nullptr, D, D, WDN + (size_t)e * D * DE, DE, 0, (i2 & 3) * 64, (i2 >> 2) * 256, lds, tid); }
    }
}

DI void conv_decode(const Params& p, int set, int idx, const float*& s0, const float*& s1, char*& dst, int& src_ld, int& K, int& mode, int& k0, int& n0, int& f8) {
    char* ws = p.ws; s1 = nullptr; f8 = 0;
    int r = idx;
    if (set == 0 && r < 1024) {
        if (r < 640) { const int l = r / 320; r %= 320; s0 = p.in[I_WIN] + (size_t)l * D * IN_COLS; src_ld = IN_COLS; f8 = F8_P1; dst = ws + O_WIN + (size_t)l * NP * D * (F8_P1 ? 1 : 2); K = D; mode = 1; n0 = (r >> 4) * 256; k0 = (r & 15) * 64; return; }
        r -= 640;
        if (r < 128) { const int ab = r >> 6; r &= 63; const int l = r >> 5; r &= 31; s0 = p.in[ab ? I_WPB : I_WPA] + (size_t)l * 512 * D; src_ld = D; f8 = F8_P5; dst = ws + (ab ? O_WPB : O_WPA) + (size_t)l * D * 512 * (F8_P5 ? 1 : 2); K = 512; mode = 0; n0 = (r >> 3) * 256; k0 = (r & 7) * 64; return; }
        r -= 128;
        if (r < 128) { const int l = r >> 6; r &= 63; s0 = p.in[I_WOUT] + (size_t)l * D * D; src_ld = D; f8 = F8_P6; dst = ws + O_WOUT + (size_t)l * D * D * (F8_P6 ? 1 : 2); K = D; mode = 0; n0 = (r >> 4) * 256; k0 = (r & 15) * 64; return; }
        r -= 128;
        if (r < 32) { const int l = r >> 4; r &= 15; s0 = p.in[I_RW] + (size_t)l * D * NE; src_ld = NE; dst = ws + O_WR + (size_t)l * NE * D * 2; K = D; mode = 0; n0 = 0; k0 = r * 64; return; }
        r -= 32;
        if (r < 64) { const int l = r >> 5; r &= 31; s0 = p.in[I_SG] + (size_t)l * D * DE; s1 = p.in[I_SU] + (size_t)l * D * DE; src_ld = DE; f8 = F8_M1; dst = ws + O_WSGU + (size_t)l * 512 * D * (F8_M1 ? 1 : 2); K = D; mode = 2; n0 = (r >> 4) * 256; k0 = (r & 15) * 64; return; }
        r -= 64;
        { const int l = r >> 4; r &= 15; s0 = p.in[I_SD] + (size_t)l * DE * D; src_ld = D; f8 = F8_M2; dst = ws + O_WSD + (size_t)l * D * DE * (F8_M2 ? 1 : 2); K = DE; mode = 0; n0 = (r >> 2) * 256; k0 = (r & 3) * 64; return; }
    }
    const int l = set; if (set == 0) r -= 1024;
    const int e = r / 48, it = r % 48;
    if (it < 32) { s0 = p.in[I_WG] + ((size_t)l * NE + e) * D * DE; s1 = p.in[I_WU] + ((size_t)l * NE + e) * D * DE; src_ld = DE; f8 = F8_M1; dst = ws + O_WGU + ((size_t)l * NE + e) * 512 * D; K = D; mode = 2; n0 = (it >> 4) * 256; k0 = (it & 15) * 64; }
    else { const int i2 = it - 32; s0 = p.in[I_WD] + ((size_t)l * NE + e) * DE * D; src_ld = D; f8 = F8_M2; dst = ws + O_WDN + ((size_t)l * NE + e) * D * DE; K = DE; mode = 0; n0 = (i2 >> 2) * 256; k0 = (i2 & 3) * 64; }
}
DI void conv_loads(f32x4 (&r)[8], const float* s0, const float* s1, int src_ld, int mode, int k0, int n0, int tid) {
    const int n = n0 + 4 * (tid & 63);
    const float* sp; bool ok = true;
    if (mode == 2) { const int tl = n >> 8, w = n & 255; sp = ((w < 128) ? s0 : s1) + tl * 128 + (w & 127); }
    else if (mode == 1) { const int c = projmap2(n); ok = c >= 0; sp = s0 + (ok ? c : 0); }
    else sp = s0 + n;
    sp += (size_t)(k0 + (tid >> 6)) * src_ld;
#pragma unroll
    for (int j = 0; j < 8; ++j) r[j] = ok ? __builtin_nontemporal_load((const f32x4*)(sp + (size_t)(8 * j) * src_ld)) : (f32x4){0.f, 0.f, 0.f, 0.f};
}
struct ConvItem { const float* s0; const float* s1; char* dst; int src_ld, K, mode, k0, n0, f8; };
DI void conv_item(const Params& p, int set, int idx, ConvItem& c) { conv_decode(p, set, idx, c.s0, c.s1, c.dst, c.src_ld, c.K, c.mode, c.k0, c.n0, c.f8); }
DI void conv_img_write(LAS char* img, const f32x4 (&r)[8], int tid) {
#pragma unroll
    for (int j = 0; j < 8; ++j) { u32x2 v; v.x = pk2(r[j][0], r[j][1]); v.y = pk2(r[j][2], r[j][3]); *(LAS u32x2*)(img + ((tid >> 6) + 8 * j) * 576 + (tid & 63) * 8) = v; }
}
DI void conv_emit(const ConvItem& c, LAS const char* img, int tid, int nostore = 0) {
    const int lane = tid & 63, w = tid >> 6, G = lane >> 4, i16 = lane & 15, q = i16 >> 2, pp = i16 & 3;
#pragma unroll
    for (int s = 0; s < 4; ++s) {
        const int combo = s * 8 + w, nb = 2 * (combo >> 2) + (G & 1), kc = 2 * (combo & 3) + (G >> 1);
        LAS const char* a = img + (8 * kc + q) * 576 + (16 * nb + 4 * pp) * 2;
        const s16x4 lo = __builtin_amdgcn_ds_read_tr16_b64_v4i16((LAS s16x4*)a);
        const s16x4 hi = __builtin_amdgcn_ds_read_tr16_b64_v4i16((LAS s16x4*)(a + 4 * 576));
        const bf16x8 o = __builtin_shufflevector(lo, hi, 0, 1, 2, 3, 4, 5, 6, 7);
        const size_t eo = (size_t)(c.n0 + 16 * nb + i16) * c.K + c.k0 + 8 * kc;
        if (c.f8) { float f[8];
#pragma unroll
            for (int j = 0; j < 8; ++j) f[j] = bf2f((unsigned short)o[j]) * WS8;
            u32x2 w8; w8.x = pk4_fp8(f[0], f[1], f[2], f[3]); w8.y = pk4_fp8(f[4], f[5], f[6], f[7]); if (!nostore) *(u32x2*)(c.dst + eo) = w8; else asm volatile("" :: "v"(w8)); }
        else if (!nostore) *(bf16x8*)(c.dst + eo * 2) = o; else asm volatile("" :: "v"(o));
    }
}
DI void conv_stream(const Params& p, int set, int total, LAS char* lds, int tid, int nostore = 0) {
    int idxA = 2 * blockIdx.x; const int stride = 2 * gridDim.x;
    __syncthreads();
    if (idxA >= total) return;
    ConvItem A, B, A2, B2; f32x4 rA[8], rB[8];
    conv_item(p, set, idxA, A); conv_loads(rA, A.s0, A.s1, A.src_ld, A.mode, A.k0, A.n0, tid);
    int idxB = idxA + 1; bool hasB = idxB < total;
    B = A; if (hasB) { conv_item(p, set, idxB, B); conv_loads(rB, B.s0, B.s1, B.src_ld, B.mode, B.k0, B.n0, tid); }
    LAS char* img0 = lds; LAS char* img1 = lds + 36864;
    for (;;) {
        conv_img_write(img0, rA, tid);
        __syncthreads();
        const int idxA2 = idxA + stride; const bool hasA2 = idxA2 < total;
        A2 = A; if (hasA2) { conv_item(p, set, idxA2, A2); conv_loads(rA, A2.s0, A2.s1, A2.src_ld, A2.mode, A2.k0, A2.n0, tid); }
        conv_emit(A, img0, tid, nostore);
        if (!hasB) break;
        conv_img_write(img1, rB, tid);
        __syncthreads();
        const int idxB2 = idxB + stride; const bool hasB2 = idxB2 < total;
        B2 = B; if (hasB2) { conv_item(p, set, idxB2, B2); conv_loads(rB, B2.s0, B2.s1, B2.src_ld, B2.mode, B2.k0, B2.n0, tid); }
        conv_emit(B, img1, tid, nostore);
        if (!hasA2) break;
        A = A2; B = B2; idxA = idxA2; idxB = idxB2; hasB = hasB2;
    }
    __syncthreads();
}
constexpr int NQ0 = NE * 24, NQ = 2 * NQ0, NQG = NE * 16;
constexpr size_t O_WQ = O_MISC + 1024;
DI void conv_pair(const Params& p, int q, LAS char* lds, int tid) {
    const int set = q >= NQ0 ? 1 : 0, ql = q - set * NQ0;
    const int it0 = ql < NQG ? (ql >> 4) * 48 + 2 * (ql & 15) : ((ql - NQG) >> 3) * 48 + 32 + 2 * ((ql - NQG) & 7);
    const int i0 = set ? it0 : 1024 + it0;
    ConvItem A, B; f32x4 rA[8], rB[8];
    conv_item(p, set, i0, A); conv_loads(rA, A.s0, A.s1, A.src_ld, A.mode, A.k0, A.n0, tid);
    conv_item(p, set, i0 + 1, B); conv_loads(rB, B.s0, B.s1, B.src_ld, B.mode, B.k0, B.n0, tid);
    conv_img_write(lds, rA, tid);
    __syncthreads();
    conv_emit(A, lds, tid);
    conv_img_write(lds + 36864, rB, tid);
    __syncthreads();
    conv_emit(B, lds + 36864, tid);
    __syncthreads();
}
DI void conv_drain(const Params& p, int limit, LAS char* lds, volatile LAS unsigned* st, int tid) {
    __syncthreads();
    for (;;) {
        if (tid == 0) st[3] = (st[3] == 0xffffffffu) ? 0xffffffffu : atomicAdd((unsigned*)(p.ws + O_WQ), 1u);
        __syncthreads();
        unsigned q = st[3];
        __syncthreads();
        if (q >= (unsigned)NQ) { if (tid == 0) st[3] = 0xffffffffu; break; }
        conv_pair(p, (int)q, lds, tid);
        if (q >= (unsigned)limit) break;
    }
    __syncthreads();
}
DI void phase_prologue(const Params& p, LAS char* lds) {
    const int tid = opaque_tid();
    const size_t gtid = (size_t)blockIdx.x * NTHREADS + tid, gstride = (size_t)gridDim.x * NTHREADS;
    char* ws = p.ws;
    { float* COS = (float*)(ws + O_COS); float* SIN = (float*)(ws + O_SIN);
      for (size_t i = gtid; i < (size_t)SEQ * 32; i += gstride) {
          const int s = (int)(i >> 5), d = (int)(i & 31);
          const float inv = exp2f(-(float)d * (13.287712379549449f / 32.0f));
          const float ang = (float)s * inv;
          const double rev = (double)ang * 0.15915494309189535;
          const double fr = rev - floor(rev);
          COS[i] = __builtin_amdgcn_cosf((float)fr); SIN[i] = __builtin_amdgcn_sinf((float)fr);
      } }
    { float* BP = (float*)(ws + O_BIASP);
      for (size_t i = gtid; i < (size_t)NL * NP; i += gstride) { const int l = (int)(i / NP), n = (int)(i % NP); const int c = projmap2(n); BP[i] = c >= 0 ? p.in[I_BIN][(size_t)l * IN_COLS + c] : 0.f; } }
    { float* PART = (float*)(ws + O_C1PART); LAS float* red = (LAS float*)lds;
      for (int u = blockIdx.x; u < NL * 2 * 64; u += gridDim.x) {
          const int lw = u & 3, kq = u >> 2, jn = tid & 127, kr = tid >> 7, k0 = kq * 32 + kr * 8;
          const float* pos = p.in[I_CPOS] + (size_t)lw * 2048; const float* w1 = p.in[I_CW1] + (size_t)lw * 2048 * 128;
          float a = 0.f;
#pragma unroll
          for (int i = 0; i < 8; ++i) a += pos[k0 + i] * w1[(size_t)(k0 + i) * 128 + jn];
          red[kr * 128 + jn] = a;
          __syncthreads();
          if (tid < 128) PART[(size_t)(lw * 64 + kq) * 128 + tid] = (red[tid] + red[128 + tid]) + (red[256 + tid] + red[384 + tid]);
          __syncthreads();
      } }
    { bf16_t* XB = (bf16_t*)(ws + O_XB0); const float* x = p.in[I_X];
      for (size_t i = gtid; i < (size_t)NT * D / 8; i += gstride) {
          const f32x4 a = *(const f32x4*)(x + i * 8), b = *(const f32x4*)(x + i * 8 + 4);
          u32x4 w; w.x = pk2(a[0], a[1]); w.y = pk2(a[2], a[3]); w.z = pk2(b[0], b[1]); w.w = pk2(b[2], b[3]);
          *(u32x4*)(XB + i * 8) = w;
          if (F8_P1) { u32x2 w8; w8.x = pk4_fp8(a[0] * XS8, a[1] * XS8, a[2] * XS8, a[3] * XS8); w8.y = pk4_fp8(b[0] * XS8, b[1] * XS8, b[2] * XS8, b[3] * XS8); *(u32x2*)(ws + O_XA8 + i * 8) = w8; }
      } }
    const int c = blockIdx.x, G = gridDim.x;
    for (int l = 0; l < NL; ++l) {
        for (int w = 0; w < 2; ++w) {
            { TrJob j{p.in[I_CW1] + (size_t)(l * 2 + w) * 2048 * 128, nullptr, 128, 128, (bf16_t*)(ws + O_W1) + (size_t)(l * 2 + w) * 128 * 2048, 2048, 0};
              const int nk = 2048 / 64;
              for (int u = c; u < nk; u += G) {
                  LAS float* T = (LAS float*)lds;
#pragma unroll
                  for (int q = 0; q < 2; ++q) { const int nn = tid & 63, n = q * 64 + nn;
#pragma unroll
                      for (int i = 0; i < 8; ++i) { const int kk = (tid >> 6) + 8 * i; T[(q * 64 + kk) * 65 + nn] = j.s0[(size_t)(u * 64 + kk) * 128 + n]; } }
                  __syncthreads();
#pragma unroll
                  for (int q = 0; q < 2; ++q) { const int nn = tid >> 3, kc = tid & 7; float v[8];
#pragma unroll
                      for (int i = 0; i < 8; ++i) v[i] = T[(q * 64 + kc * 8 + i) * 65 + nn];
                      u32x4 wv; wv.x = pk2(v[0], v[1]); wv.y = pk2(v[2], v[3]); wv.z = pk2(v[4], v[5]); wv.w = pk2(v[6], v[7]);
                      *(u32x4*)(j.dst + (size_t)(q * 64 + nn) * 2048 + u * 64 + kc * 8) = wv; }
                  __syncthreads();
              } }
            {
              bf16_t* dst = (bf16_t*)(ws + O_W2) + (size_t)(l * 2 + w) * 128 * 128; const float* src = p.in[I_CW2] + (size_t)(l * 2 + w) * 128 * 64;
              if (c == (l * 2 + w) % G) for (int i = tid; i < 128 * 128; i += NTHREADS) { const int n = i >> 7, k = i & 127; const float v = n < 64 ? src[k * 64 + n] : 0.f; dst[i] = (bf16_t)(pk2(v, 0.f) & 0xffffu); } }
        }
    }
    conv_stream(p, 0, 1024, lds, tid);
}

DI void proj_epilogue(const Params& p, int l, const f32x4 (&acc)[4][4], int rt, int ct, int wm, int wn, int fr, int fq) {
    char* R = p.ws + O_R;
    const float* bias = (const float*)(p.ws + O_BIASP) + (size_t)l * NP + ct * 128 + wn * 64;
    f32x4 bv[4];
#pragma unroll
    for (int n = 0; n < 4; ++n) bv[n] = *(const f32x4*)(bias + 16 * n + 4 * fq);
    int kind, head = 0, H = 1; bf16_t* dst = nullptr;
    if (ct < 4) { kind = 0; head = 2 * ct + wn; H = 8; }
    else if (ct < 10) { const int sec = ct - 4; head = wn; H = 2; kind = (sec == 2 || sec == 4) ? 2 : 1;
        const size_t off = sec == 0 ? R_KC : sec == 1 ? R_VC : sec == 2 ? R_KS : sec == 3 ? R_VS : sec == 4 ? R_KW : R_VW; dst = (bf16_t*)(R + off); }
    else if (ct < 14) { kind = 2; head = 2 * (ct - 10) + wn; H = 8; dst = (bf16_t*)(R + R_QB); }
    else if (ct < 18) { kind = 2; head = 2 * (ct - 14) + wn; H = 8; dst = (bf16_t*)(R + R_KB); }
    else if (ct < 22) { kind = 1; head = 2 * (ct - 18) + wn; H = 8; dst = (bf16_t*)(R + R_VB); }
    else if (ct < 30) { kind = 3; head = (ct - 22) * 128 + wn * 64; dst = (bf16_t*)(R + R_MA); }
    else if (ct < 38) { kind = 3; head = (ct - 30) * 128 + wn * 64; dst = (bf16_t*)(R + R_MB); }
    else { kind = 4; }
    const float* COS = (const float*)(p.ws + O_COS); const float* SIN = (const float*)(p.ws + O_SIN);
#pragma unroll
    for (int m = 0; m < 4; ++m) {
        const int t = rt * 256 + wm * 64 + 16 * m + fr, b = t >> 12, s = t & 4095;
        f32x4 v[4];
#pragma unroll
        for (int n = 0; n < 4; ++n) v[n] = acc[m][n] + bv[n];
        if (kind == 0 || kind == 2) {
            const f32x4 c0 = *(const f32x4*)(COS + s * 32 + 4 * fq), c1 = *(const f32x4*)(COS + s * 32 + 16 + 4 * fq);
            const f32x4 s0 = *(const f32x4*)(SIN + s * 32 + 4 * fq), s1 = *(const f32x4*)(SIN + s * 32 + 16 + 4 * fq);
            f32x4 r[4];
            r[0] = v[0] * c0 - v[2] * s0; r[2] = v[2] * c0 + v[0] * s0;
            r[1] = v[1] * c1 - v[3] * s1; r[3] = v[3] * c1 + v[1] * s1;
            const size_t o = ((size_t)((b * H + head) * SEQ + s)) * 64 + 4 * fq;
            if (kind == 0) {
                bf16_t* qa = (bf16_t*)(R + R_QA) + o; bf16_t* qar = (bf16_t*)(R + R_QAR) + o;
#pragma unroll
                for (int n = 0; n < 4; ++n) { st_bf16x4(qa + 16 * n, v[n]); st_bf16x4(qar + 16 * n, r[n]); }
            } else {
#pragma unroll
                for (int n = 0; n < 4; ++n) st_bf16x4(dst + o + 16 * n, r[n]);
            }
        } else if (kind == 1) {
            const size_t o = ((size_t)((b * H + head) * SEQ + s)) * 64 + 4 * fq;
#pragma unroll
            for (int n = 0; n < 4; ++n) st_bf16x4(dst + o + 16 * n, v[n]);
        } else if (kind == 3) {
            bf16_t* o = dst + (size_t)t * D + head + 4 * fq;
#pragma unroll
            for (int n = 0; n < 4; ++n) { f32x4 g; g[0] = sigmoidf_(v[n][0]); g[1] = sigmoidf_(v[n][1]); g[2] = sigmoidf_(v[n][2]); g[3] = sigmoidf_(v[n][3]); st_bf16x4(o + 16 * n, g); }
        } else {
            if (wn == 0) { float* ga = (float*)(R + R_GA) + (size_t)t * 24;
#pragma unroll
                for (int n = 0; n < 2; ++n)
#pragma unroll
                    for (int q = 0; q < 4; ++q) { const int cidx = 16 * n + 4 * fq + q; if (cidx < 24) ga[cidx] = sigmoidf_(v[n][q]); } }
        }
    }
}
DI void thread_rc(int tid, int& R0, int& C0) { stage_rc(tid * 16, R0, C0); }

DI void phase_proj(const Params& p, int l, LAS char* lds) {
    const int tid = opaque_tid(), lane = tid & 63, wid = tid >> 6, wm = wid >> 1, wn = wid & 1, fr = lane & 15, fq = lane >> 4;
    int R0, C0; thread_rc(tid, R0, C0);
    const bf16_t* A = (const bf16_t*)(p.ws + (l == 0 ? O_XB0 : O_XB1));
    const bf16_t* Bt = (const bf16_t*)(p.ws + O_WIN) + (size_t)l * NP * D;
    if (blockIdx.x < 2 && tid < 128) {
        const int lw = 2 * l + blockIdx.x; const float* PART = (const float*)(p.ws + O_C1PART) + (size_t)lw * 64 * 128;
        float a = p.in[I_CB1][lw * 128 + tid];
        for (int kq = 0; kq < 64; ++kq) a += PART[kq * 128 + tid];
        ((float*)(p.ws + O_C1))[lw * 128 + tid] = a;
    }
    for (int u = blockIdx.x; u < 128 * 39; u += gridDim.x) {
        const int rt = u / 39, ct = u % 39;
        const bf16_t* ap[4]; const bf16_t* bp[2];
#pragma unroll
        for (int i = 0; i < 4; ++i) ap[i] = A + (size_t)(rt * 256 + R0 + 64 * i) * D + C0;
#pragma unroll
        for (int i = 0; i < 2; ++i) bp[i] = Bt + (size_t)(ct * 128 + R0 + 64 * i) * D + C0;
        f32x4 acc[4][4]; zero_acc(acc);
        gemm_kloop<4, 2>(acc, ap, bp, D / 64, lds, tid);
        proj_epilogue(p, l, acc, rt, ct, wm, wn, fr, fq);
    }
}

DI float gelu_tanh(float x) { const float u = 0.7978845608028654f * (x + 0.044715f * x * x * x); const float e = __expf(2.0f * u); return 0.5f * x * (1.0f + (1.0f - 2.0f * frcp(e + 1.0f))); }
DI void phase_compress1(const Params& p, int l, LAS char* lds) {
    const int tid = opaque_tid(), lane = tid & 63, wid = tid >> 6, wm = wid >> 1, wn = wid & 1, fr = lane & 15, fq = lane >> 4;
    int R0, C0; thread_rc(tid, R0, C0);
    char* R = p.ws + O_R;
    for (int u = blockIdx.x; u < 32; u += gridDim.x) {
        const int w = u >> 4, bg = u & 15;
        const bf16_t* A = (const bf16_t*)(R + (w ? R_VC : R_KC)) + (size_t)bg * SEQ * 64;
        const bf16_t* Bt = (const bf16_t*)(p.ws + O_W1) + (size_t)(l * 2 + w) * 128 * 2048;
        const bf16_t* ap[4]; const bf16_t* bp[2];
#pragma unroll
        for (int i = 0; i < 4; ++i) ap[i] = A + (size_t)(R0 + 64 * i) * 1024 + C0;
#pragma unroll
        for (int i = 0; i < 2; ++i) bp[i] = Bt + (size_t)(R0 + 64 * i) * 2048 + C0;
        f32x4 acc[4][4]; zero_acc(acc);
        gemm_kloop<4, 2>(acc, ap, bp, 2048 / 64, lds, tid);
        const float* c1 = (const float*)(p.ws + O_C1) + (size_t)(l * 2 + w) * 128 + wn * 64;
        bf16_t* hid = (bf16_t*)(R + R_HID) + (size_t)(w * 16 + bg) * 256 * 128;
#pragma unroll
        for (int m = 0; m < 4; ++m) {
            const int row = wm * 64 + 16 * m + fr;
#pragma unroll
            for (int n = 0; n < 4; ++n) {
                const f32x4 cv = *(const f32x4*)(c1 + 16 * n + 4 * fq);
                f32x4 v = acc[m][n] + cv;
#pragma unroll
                for (int q = 0; q < 4; ++q) v[q] = (row < 255) ? gelu_tanh(v[q]) : 0.f;
                st_bf16x4(hid + (size_t)row * 128 + wn * 64 + 16 * n + 4 * fq, v);
            }
        }
    }
    {
        LAS float* red = (LAS float*)lds;
        const bf16_t* KB = (const bf16_t*)(R + R_KB); float* KM = (float*)(R + R_KMEAN);
        const int first = (blockIdx.x >= 32) ? (int)blockIdx.x - 32 : (int)blockIdx.x + (int)gridDim.x - 32;
        const int stride = gridDim.x;
        for (int u = first; u < 1024; u += stride) {
            if (u < 0) continue;
            const int bh = u >> 4, n = u & 15;
            const bf16_t* src = KB + ((size_t)bh * SEQ + n * 256) * 64;
            const int kr = tid >> 3, ch = tid & 7;
            float a[8];
#pragma unroll
            for (int j = 0; j < 8; ++j) a[j] = 0.f;
#pragma unroll
            for (int q = 0; q < 4; ++q) { const bf16x8 v = *(const bf16x8*)(src + (size_t)(kr + 64 * q) * 64 + ch * 8);
#pragma unroll
                for (int j = 0; j < 8; ++j) a[j] += bf2f((unsigned short)v[j]); }
#pragma unroll
            for (int j = 0; j < 8; ++j) red[kr * 65 + ch * 8 + j] = a[j];
            __syncthreads();
            if (tid < 64) { float s = 0.f; for (int k = 0; k < 64; ++k) s += red[k * 65 + tid]; KM[(size_t)u * 64 + tid] = s * (1.0f / 256.0f); }
            __syncthreads();
        }
    }
}
DI void phase_compress2(const Params& p, int l, LAS char* lds) {
    const int tid = opaque_tid(), lane = tid & 63, wid = tid >> 6, wm = wid >> 1, wn = wid & 1, fr = lane & 15, fq = lane >> 4;
    int R0, C0; thread_rc(tid, R0, C0);
    char* R = p.ws + O_R;
    for (int u = blockIdx.x; u < 32; u += gridDim.x) {
        const int w = u >> 4, bg = u & 15;
        const bf16_t* A = (const bf16_t*)(R + R_HID) + (size_t)(w * 16 + bg) * 256 * 128;
        const bf16_t* Bt = (const bf16_t*)(p.ws + O_W2) + (size_t)(l * 2 + w) * 128 * 128;
        const bf16_t* ap[4]; const bf16_t* bp[2];
#pragma unroll
        for (int i = 0; i < 4; ++i) ap[i] = A + (size_t)(R0 + 64 * i) * 128 + C0;
#pragma unroll
        for (int i = 0; i < 2; ++i) bp[i] = Bt + (size_t)(R0 + 64 * i) * 128 + C0;
        f32x4 acc[4][4]; zero_acc(acc);
        gemm_kloop<4, 2>(acc, ap, bp, 2, lds, tid);
        if (wn == 0) {
            bf16_t* dst = (bf16_t*)(R + (w ? R_VCC : R_KCC)) + (size_t)bg * 256 * 64;
#pragma unroll
            for (int m = 0; m < 4; ++m) { const int row = wm * 64 + 16 * m + fr;
#pragma unroll
                for (int n = 0; n < 4; ++n) st_bf16x4(dst + (size_t)row * 64 + 16 * n + 4 * fq, acc[m][n]); }
        }
    }
}

struct Flash { f32x16 o[2]; float m, l; };
DI void flash_init(Flash& f) {
#pragma unroll
    for (int i = 0; i < 16; ++i) { f.o[0][i] = 0.f; f.o[1][i] = 0.f; }
    f.m = 0.f; f.l = 0.f;
}
DI void kv_stage_write(LAS char* Kt, LAS char* Vt, u32x4 kr, u32x4 vr, int tid) {
    const int key = tid >> 3, ch = tid & 7;
    *(LAS u32x4*)(Kt + key * 144 + ch * 16) = kr;
    *(LAS u32x4*)(Vt + 1024 * (key >> 3) + 512 * (ch >> 2) + 64 * (key & 7) + 16 * (ch & 3)) = vr;
}
DI void qk_tile(f32x16& s0, f32x16& s1, const bf16x8 (&qf)[4], LAS const char* Kt, int r, int hh, float init = 0.f) {
#pragma unroll
    for (int i = 0; i < 16; ++i) { s0[i] = init; s1[i] = init; }
    LAS const char* base = Kt + r * 144 + hh * 16;
#pragma unroll
    for (int ks = 0; ks < 4; ++ks) {
        const bf16x8 a0 = *(LAS const bf16x8*)(base + ks * 32), a1 = *(LAS const bf16x8*)(base + 32 * 144 + ks * 32);
        s0 = mfma32(a0, qf[ks], s0); s1 = mfma32(a1, qf[ks], s1);
    }
}
DI bf16x8 pack8(const f32x16& s, int h8) {
    u32x4 w;
    w.x = pk2(s[h8 * 8 + 0], s[h8 * 8 + 1]); w.y = pk2(s[h8 * 8 + 2], s[h8 * 8 + 3]); w.z = pk2(s[h8 * 8 + 4], s[h8 * 8 + 5]); w.w = pk2(s[h8 * 8 + 6], s[h8 * 8 + 7]);
    return __builtin_bit_cast(bf16x8, w);
}
DI void pv_load(bf16x8 (&vf)[2][2][2], LAS const char* Vt, int lane) {
    const int i16 = lane & 15, q = i16 >> 2, pp = i16 & 3, G = lane >> 4;
    LAS const char* vb = Vt + 64 * (4 * (G >> 1) + q) + 32 * (G & 1) + 8 * pp;
#pragma unroll
    for (int kb = 0; kb < 2; ++kb)
#pragma unroll
        for (int sp = 0; sp < 2; ++sp)
#pragma unroll
            for (int db = 0; db < 2; ++db) {
                const s16x4 lo = __builtin_amdgcn_ds_read_tr16_b64_v4i16((LAS s16x4*)(vb + 4096 * kb + 2048 * sp + 512 * db));
                const s16x4 hi = __builtin_amdgcn_ds_read_tr16_b64_v4i16((LAS s16x4*)(vb + 4096 * kb + 2048 * sp + 512 * db + 1024));
                vf[kb][sp][db] = __builtin_shufflevector(lo, hi, 0, 1, 2, 3, 4, 5, 6, 7);
            }
}
DI void pv_mma(f32x16 (&o)[2], const f32x16& p0, const f32x16& p1, const bf16x8 (&vf)[2][2][2]) {
    bf16x8 pk[2][2];
    pk[0][0] = pack8(p0, 0); pk[0][1] = pack8(p0, 1); pk[1][0] = pack8(p1, 0); pk[1][1] = pack8(p1, 1);
#pragma unroll
    for (int kb = 0; kb < 2; ++kb)
#pragma unroll
        for (int sp = 0; sp < 2; ++sp)
#pragma unroll
            for (int db = 0; db < 2; ++db) o[db] = mfma32(vf[kb][sp][db], pk[kb][sp], o[db]);
}
DI void pv_tile(f32x16 (&o)[2], const f32x16& p0, const f32x16& p1, LAS const char* Vt, int lane) {
    bf16x8 vf[2][2][2]; pv_load(vf, Vt, lane); pv_mma(o, p0, p1, vf);
}
DI void mask_tile(f32x16& s0, f32x16& s1, int key0, bool rowok, int klo, int khi, int hh) {
    int lo2 = klo, span = khi - klo;
    if (!rowok || span < 0) { lo2 = 0x3fffffff; span = 0; }
    const int kb0 = key0 + 4 * hh - lo2;
#pragma unroll
    for (int i = 0; i < 16; ++i) {
        const int cr = (i & 3) + 8 * (i >> 2);
        s0[i] = ((unsigned)(kb0 + cr) <= (unsigned)span) ? s0[i] : -INFINITY;
        s1[i] = ((unsigned)(kb0 + 32 + cr) <= (unsigned)span) ? s1[i] : -INFINITY;
    }
}
DI void flash_step(Flash& f, const bf16x8 (&qf)[4], LAS const char* Kt, LAS const char* Vt, int key0, bool rowok, int klo, int khi, int lane) {
    const int r = lane & 31, hh = lane >> 5;
    const bool inside = klo <= key0 && khi >= key0 + 63;
    const bool fast = __all(inside || !rowok);
    const bool off = fast && !rowok;
    f32x16 s0, s1; qk_tile(s0, s1, qf, Kt, r, hh, off ? -INFINITY : -f.m);
    bf16x8 vf[2][2][2]; pv_load(vf, Vt, lane);
    __builtin_amdgcn_sched_barrier(0);
    if (!fast) mask_tile(s0, s1, key0, rowok, klo, khi, hh);
    float mx = -INFINITY;
#pragma unroll
    for (int i = 0; i < 16; ++i) mx = max3f(mx, s0[i], s1[i]);
    mx = fmaxf(mx, shx(mx, 32));
    const bool fresh = f.l == 0.f && mx > -INFINITY;
    const bool move = mx > 8.0f || (fresh && mx < -8.0f);
    if (__any(move)) {
        const float d = move ? mx : 0.f;
        const float alpha = (f.l == 0.f) ? 1.0f : fexp2(-d);
#pragma unroll
        for (int i = 0; i < 16; ++i) { s0[i] -= d; s1[i] -= d; f.o[0][i] *= alpha; f.o[1][i] *= alpha; }
        f.l *= alpha; f.m += d;
    }
    float rs = 0.f;
#pragma unroll
    for (int i = 0; i < 16; ++i) { s0[i] = fexp2(s0[i]); s1[i] = fexp2(s1[i]); rs += s0[i] + s1[i]; }
    rs += shx(rs, 32);
    f.l += rs;
    pv_mma(f.o, s0, s1, vf);
}
struct FlPre { u32x4 k, v; bool has; };
struct FlNext { const bf16_t* Kg; const bf16_t* Vg; int j; };
template <class Seq, class MaskFn>
DI void flash_loop(Flash& f, const bf16x8 (&qf)[4], const bf16_t* Kg, const bf16_t* Vg, Seq seq, MaskFn mf, LAS char* lds, int tid, FlPre* pre = nullptr, FlNext nx = FlNext{nullptr, nullptr, -1}) {
    const int lane = tid & 63;
#define FL_BAR() do { asm volatile("s_waitcnt lgkmcnt(0)" ::: "memory"); __builtin_amdgcn_s_barrier(); asm volatile("" ::: "memory"); } while (0)
    FL_BAR();
    int jc = seq.first();
    if (jc < 0) { if (pre) pre->has = false; return; }
    int j1 = seq.next(jc), j2 = j1 >= 0 ? seq.next(j1) : -1;
    u32x4 kA, vA, kB = {0u, 0u, 0u, 0u}, vB = {0u, 0u, 0u, 0u};
#define FL_LOAD(j, kr, vr) do { kr = *(const u32x4*)(Kg + (size_t)(j) * 4096 + tid * 8); vr = *(const u32x4*)(Vg + (size_t)(j) * 4096 + tid * 8); } while (0)
#define FL_STEP(j, bf) do { bool rowok; int klo, khi; mf((j), rowok, klo, khi); const int key0 = (j) * 64; \
        const bool need = rowok && khi >= key0 && klo <= key0 + 63; \
        if (__any(need)) flash_step(f, qf, lds + (bf) * 9216, lds + 18432 + (bf) * 8192, key0, rowok, klo, khi, lane); } while (0)
    if (pre && pre->has) { kA = pre->k; vA = pre->v; } else FL_LOAD(jc, kA, vA);
    kv_stage_write(lds, lds + 18432, kA, vA, tid);
    FL_BAR();
    if (j1 >= 0) FL_LOAD(j1, kA, vA);
    if (j2 >= 0) FL_LOAD(j2, kB, vB);
    if (pre) { pre->has = nx.j >= 0; if (nx.j >= 0) { pre->k = *(const u32x4*)(nx.Kg + (size_t)nx.j * 4096 + tid * 8); pre->v = *(const u32x4*)(nx.Vg + (size_t)nx.j * 4096 + tid * 8); } }
    for (;;) {
        FL_STEP(jc, 0);
        if (j1 < 0) break;
        kv_stage_write(lds + 9216, lds + 18432 + 8192, kA, vA, tid);
        const int j3 = j2 >= 0 ? seq.next(j2) : -1;
        if (j3 >= 0) FL_LOAD(j3, kA, vA);
        FL_BAR();
        FL_STEP(j1, 1);
        if (j2 < 0) break;
        kv_stage_write(lds, lds + 18432, kB, vB, tid);
        const int j4 = j3 >= 0 ? seq.next(j3) : -1;
        if (j4 >= 0) FL_LOAD(j4, kB, vB);
        FL_BAR();
        jc = j2; j1 = j3; j2 = j4;
    }
    FL_BAR();
#undef FL_BAR
#undef FL_LOAD
#undef FL_STEP
}
struct SeqRange { int a, b; DI int first() const { return a <= b ? a : -1; } DI int next(int j) const { return j < b ? j + 1 : -1; } };
struct SeqMask { unsigned long long m; DI int first() const { return m ? (int)__builtin_ctzll(m) : -1; }
    DI int next(int j) const { const unsigned long long r = (j >= 63) ? 0ull : (m >> (j + 1)); return r ? j + 1 + (int)__builtin_ctzll(r) : -1; } };

DI void load_qf(bf16x8 (&qf)[4], const bf16_t* qrow, int hh) {
#pragma unroll
    for (int ks = 0; ks < 4; ++ks) qf[ks] = *(const bf16x8*)(qrow + 16 * ks + 8 * hh);
}
DI unsigned long long shx64(unsigned long long v, int m) { const unsigned lo = __shfl_xor((unsigned)v, m), hi = __shfl_xor((unsigned)(v >> 32), m); return ((unsigned long long)hi << 32) | lo; }

DI void lane_o_store(bf16_t* row, const f32x16 (&o)[2], float sc, int hh) {
#pragma unroll
    for (int db = 0; db < 2; ++db)
#pragma unroll
        for (int ap = 0; ap < 2; ++ap) {
            u32x4 w; w.x = pk2(o[db][8 * ap] * sc, o[db][8 * ap + 1] * sc); w.y = pk2(o[db][8 * ap + 2] * sc, o[db][8 * ap + 3] * sc);
            w.z = pk2(o[db][8 * ap + 4] * sc, o[db][8 * ap + 5] * sc); w.w = pk2(o[db][8 * ap + 6] * sc, o[db][8 * ap + 7] * sc);
            *(u32x4*)(row + 32 * hh + 16 * db + 8 * ap) = w;
        }
}
DI void lane_o_load(bf16x8 (&raw)[2][2], const bf16_t* row, int hh, bool on) {
#pragma unroll
    for (int db = 0; db < 2; ++db)
#pragma unroll
        for (int ap = 0; ap < 2; ++ap) raw[db][ap] = on ? *(const bf16x8*)(row + 32 * hh + 16 * db + 8 * ap) : (bf16x8){0, 0, 0, 0, 0, 0, 0, 0};
}
constexpr int WIN_SPLIT = 32;
DI void nsa_win_unit(const Params& p, int b, int g, int qb, LAS char* lds, int tid) {
    char* R = p.ws + O_R;
    const int lane = tid & 63, w = tid >> 6, r = lane & 31, hh = lane >> 5;
    const int qi = 8 * w + (r >> 2), head = 4 * g + (r & 3), qpos = 64 * qb + qi, t = b * SEQ + qpos;
    const size_t qoff = ((size_t)((b * 8 + head) * SEQ + qpos)) * 64;
    const float g2 = ((const float*)(R + R_GA))[(size_t)t * 24 + head * 3 + 2];
    bf16_t* oa = (bf16_t*)(R + R_OA) + (size_t)t * 512 + head * 64;
    bf16x8 qf[4]; load_qf(qf, (const bf16_t*)(R + R_QAR) + qoff, hh);
    Flash f; flash_init(f);
    const bf16_t* Kg = (const bf16_t*)(R + R_KW) + (size_t)(b * 2 + g) * SEQ * 64;
    const bf16_t* Vg = (const bf16_t*)(R + R_VW) + (size_t)(b * 2 + g) * SEQ * 64;
    const int qp = qpos;
    flash_loop(f, qf, Kg, Vg, SeqRange{qb >= 8 ? qb - 8 : 0, qb}, [qp](int, bool& ok, int& klo, int& khi) { ok = true; klo = qp - 511; khi = qp; }, lds, tid);
    lane_o_store(oa, f.o, (f.l > 0.f ? 1.0f / f.l : 0.f) * g2, hh);
}
DI void nsa_unit(const Params& p, int b, int g, int qb, LAS char* lds, int tid_) {
    char* R = p.ws + O_R; (void)tid_;
    const int tid = opaque_tid();
    const int lane = tid & 63, w = tid >> 6, r = lane & 31, hh = lane >> 5;
    const int qi = 8 * w + (r >> 2), head = 4 * g + (r & 3), qpos = 64 * qb + qi, t = b * SEQ + qpos;
    const size_t qoff = ((size_t)((b * 8 + head) * SEQ + qpos)) * 64;
    const float* ga = (const float*)(R + R_GA) + (size_t)t * 24 + head * 3;
    const float g0 = ga[0], g1 = ga[1], g2 = ga[2];
    bf16_t* oa = (bf16_t*)(R + R_OA) + (size_t)t * 512 + head * 64;
    unsigned char* oa8 = F8_P5 ? (unsigned char*)(p.ws + O_OA8) + (size_t)t * 512 + head * 64 : nullptr;
    f32x16 tot[2];
#pragma unroll
    for (int i = 0; i < 16; ++i) { tot[0][i] = 0.f; tot[1][i] = 0.f; }
    unsigned long long selmask = 0ull;
    {
        LAS char* Kc = lds; LAS char* Vc = lds + 36864;
        const int ntile = ((4 * qb + 2) >> 6) + 1;
        const bf16_t* kcg = (const bf16_t*)(R + R_KCC) + (size_t)(b * 2 + g) * 256 * 64;
        const bf16_t* vcg = (const bf16_t*)(R + R_VCC) + (size_t)(b * 2 + g) * 256 * 64;
        __syncthreads();
        for (int tl = 0; tl < ntile; ++tl) {
            const u32x4 kr = *(const u32x4*)(kcg + (size_t)tl * 4096 + tid * 8), vr = *(const u32x4*)(vcg + (size_t)tl * 4096 + tid * 8);
            kv_stage_write(Kc + tl * 9216, Vc + tl * 8192, kr, vr, tid);
        }
        bf16x8 qf[4]; load_qf(qf, (const bf16_t*)(R + R_QA) + qoff, hh);
        __syncthreads();
        const int nvis = (qpos - 31) >> 4;
        float m = NEGF, lsum = 0.f;
#pragma unroll 1
        for (int tl = 0; tl < ntile; ++tl) {
            f32x16 s0, s1; qk_tile(s0, s1, qf, Kc + tl * 9216, r, hh);
            mask_tile(s0, s1, tl * 64, true, 0, nvis, hh);
            float mx = -INFINITY;
#pragma unroll
            for (int i = 0; i < 16; ++i) mx = fmaxf(mx, fmaxf(s0[i], s1[i]));
            mx = fmaxf(mx, shx(mx, 32));
            const float mn = fmaxf(m, mx), mc = mn;
            float rs = 0.f;
#pragma unroll
            for (int i = 0; i < 16; ++i) rs += fexp2(s0[i] - mc) + fexp2(s1[i] - mc);
            rs += shx(rs, 32);
            lsum = lsum * fexp2(m - mn) + rs; m = mn;
        }
        const float inv = lsum > 0.f ? 1.0f / lsum : 0.f, mc = m;
        f32x16 o[2];
#pragma unroll
        for (int i = 0; i < 16; ++i) { o[0][i] = 0.f; o[1][i] = 0.f; }
        LAS float* IMPw = (LAS float*)(lds + 69632) + w * 512 + (r >> 2) * 64;
        float carry = 0.f;
#pragma unroll 1
        for (int tl = 0; tl < 4; ++tl) {
            float iv[8];
#pragma unroll
            for (int k = 0; k < 8; ++k) iv[k] = 0.f;
            iv[0] = carry; carry = 0.f;
            if (tl < ntile) {
                f32x16 s0, s1; qk_tile(s0, s1, qf, Kc + tl * 9216, r, hh);
                mask_tile(s0, s1, tl * 64, true, 0, nvis, hh);
#pragma unroll
                for (int i = 0; i < 16; ++i) { s0[i] = fexp2(s0[i] - mc) * inv; s1[i] = fexp2(s1[i] - mc) * inv; }
#pragma unroll
                for (int kb = 0; kb < 2; ++kb)
#pragma unroll
                    for (int a = 0; a < 4; ++a) {
                        const int k = kb * 4 + a;
                        const float p0 = kb ? s1[4 * a] : s0[4 * a], p1 = kb ? s1[4 * a + 1] : s0[4 * a + 1], p2 = kb ? s1[4 * a + 2] : s0[4 * a + 2], p3 = kb ? s1[4 * a + 3] : s0[4 * a + 3];
                        iv[k] += 2.0f * (p0 + p1 + p2) + p3;
                        const float rcv = shx(p3, 32);
                        iv[k] += hh ? rcv : 0.f;
                        if (k + 1 < 8) iv[k + 1] += hh ? 0.f : rcv; else carry = hh ? 0.f : rcv;
                    }
                pv_tile(o, s0, s1, Vc + tl * 8192, lane);
            }
#pragma unroll
            for (int k = 0; k < 8; ++k) { iv[k] += shx(iv[k], 1); iv[k] += shx(iv[k], 2); }
            if ((r & 3) == 0) {
#pragma unroll
                for (int k = 0; k < 8; ++k) IMPw[2 * (tl * 8 + k) + hh] = iv[k];
            }
        }
#pragma unroll
        for (int i = 0; i < 16; ++i) { tot[0][i] += o[0][i] * g0; tot[1][i] += o[1][i] * g0; }
        asm volatile("s_waitcnt lgkmcnt(0)" ::: "memory");
        const int sub = (r & 3) * 2 + hh, jb = 8 * sub;
        float v[8]; int rank[8];
#pragma unroll
        for (int c = 0; c < 8; ++c) { const int j = jb + c; const float x = IMPw[j];
            v[c] = (j == 0 || j == qb || j == qb - 1) ? BIGF : (j <= qb ? x : NEGF); rank[c] = 0; }
        if (qb >= 16) for (int j2 = 0; j2 <= qb; ++j2) {
            const float x = IMPw[j2];
            const float x2 = (j2 == 0 || j2 == qb || j2 == qb - 1) ? BIGF : (j2 <= qb ? x : NEGF);
#pragma unroll
            for (int c = 0; c < 8; ++c) rank[c] += ((x2 > v[c]) || (x2 == v[c] && j2 < jb + c)) ? 1 : 0;
        }
        unsigned bits = 0;
#pragma unroll
        for (int c = 0; c < 8; ++c) bits |= (rank[c] < 16 && (jb + c) <= qb) ? (1u << c) : 0u;
        const unsigned part = bits << (8 * (sub & 3));
        unsigned long long mk = (sub < 4) ? (unsigned long long)part : ((unsigned long long)part << 32);
        mk |= shx64(mk, 1); mk |= shx64(mk, 2); mk |= shx64(mk, 32);
        selmask = mk;
    }
    unsigned long long uni = selmask;
    uni |= shx64(uni, 4); uni |= shx64(uni, 8); uni |= shx64(uni, 16);
    LAS unsigned long long* UNI = (LAS unsigned long long*)(lds + 69632 + 16384);
    __syncthreads();
    if (lane == 0) UNI[w] = uni;
    __syncthreads();
    uni = 0ull;
#pragma unroll
    for (int i = 0; i < 8; ++i) uni |= UNI[i];
    { const unsigned ulo = __builtin_amdgcn_readfirstlane((unsigned)uni), uhi = __builtin_amdgcn_readfirstlane((unsigned)(uni >> 32)); uni = ((unsigned long long)uhi << 32) | ulo; }
    bf16x8 qf[4]; load_qf(qf, (const bf16_t*)(R + R_QAR) + qoff, hh);
    bf16x8 oldw[2][2];
    lane_o_load(oldw, oa, hh, qb >= WIN_SPLIT);
    {
        Flash f; flash_init(f);
        const bf16_t* Kg = (const bf16_t*)(R + R_KS) + (size_t)(b * 2 + g) * SEQ * 64;
        const bf16_t* Vg = (const bf16_t*)(R + R_VS) + (size_t)(b * 2 + g) * SEQ * 64;
        const unsigned long long sm = selmask; const int qp = qpos;
        flash_loop(f, qf, Kg, Vg, SeqMask{uni}, [sm, qp](int j, bool& ok, int& klo, int& khi) { ok = (sm >> j) & 1ull; klo = 0; khi = qp; }, lds, tid);
        const float sc = (f.l > 0.f ? 1.0f / f.l : 0.f) * g1;
#pragma unroll
        for (int i = 0; i < 16; ++i) { tot[0][i] += f.o[0][i] * sc; tot[1][i] += f.o[1][i] * sc; }
    }
    if (qb < WIN_SPLIT) {
        Flash f; flash_init(f);
        const bf16_t* Kg = (const bf16_t*)(R + R_KW) + (size_t)(b * 2 + g) * SEQ * 64;
        const bf16_t* Vg = (const bf16_t*)(R + R_VW) + (size_t)(b * 2 + g) * SEQ * 64;
        const int qp = qpos;
        flash_loop(f, qf, Kg, Vg, SeqRange{qb >= 8 ? qb - 8 : 0, qb}, [qp](int, bool& ok, int& klo, int& khi) { ok = true; klo = qp - 511; khi = qp; }, lds, tid);
        const float sc = (f.l > 0.f ? 1.0f / f.l : 0.f) * g2;
#pragma unroll
        for (int i = 0; i < 16; ++i) { tot[0][i] += f.o[0][i] * sc; tot[1][i] += f.o[1][i] * sc; }
    }
#pragma unroll
    for (int db = 0; db < 2; ++db)
#pragma unroll
        for (int a = 0; a < 4; ++a) {
            f32x4 v4;
#pragma unroll
            for (int j = 0; j < 4; ++j) v4[j] = tot[db][4 * a + j] + bf2f((unsigned short)oldw[db][a >> 1][4 * (a & 1) + j]);
            if (F8_P5) *(unsigned*)(oa8 + 32 * db + 8 * a + 4 * hh) = pk4_fp8(v4[0] * OS8, v4[1] * OS8, v4[2] * OS8, v4[3] * OS8);
            else st_bf16x4(oa + 32 * db + 8 * a + 4 * hh, v4);
        }
}

DI void moba_unit(const Params& p, int b, int h, int qblk, LAS char* lds, int tid) {
    char* R = p.ws + O_R;
    const int lane = tid & 63, w = tid >> 6, r = lane & 31, hh = lane >> 5;
    const int qpos = 256 * qblk + 32 * w + r, t = b * SEQ + qpos;
    const size_t slab = (size_t)(b * 8 + h) * SEQ * 64;
    bf16x8 qf[4]; load_qf(qf, (const bf16_t*)(R + R_QB) + slab + (size_t)qpos * 64, hh);
    LAS float* KM = (LAS float*)(lds + 36864);
    __syncthreads();
    { const float* km = (const float*)(R + R_KMEAN) + (size_t)(b * 8 + h) * 1024; KM[tid] = km[tid]; KM[tid + 512] = km[tid + 512]; }
    __syncthreads();
    float dot[16];
#pragma unroll
    for (int n = 0; n < 16; ++n) {
        float a = 0.f;
        if (n < qblk) {
#pragma unroll
            for (int ks = 0; ks < 4; ++ks) {
                const f32x4 k0 = *(LAS const f32x4*)(KM + n * 64 + 16 * ks + 8 * hh), k1 = *(LAS const f32x4*)(KM + n * 64 + 16 * ks + 8 * hh + 4);
#pragma unroll
                for (int j = 0; j < 4; ++j) { a += bf2f((unsigned short)qf[ks][j]) * k0[j]; a += bf2f((unsigned short)qf[ks][4 + j]) * k1[j]; }
            }
            a += shx(a, 32);
        }
        dot[n] = a;
    }
    unsigned bm = 0;
#pragma unroll
    for (int it = 0; it < 3; ++it) {
        float best = -INFINITY; int bi = -1;
#pragma unroll
        for (int n = 0; n < 16; ++n) { const bool cand = (n < qblk) && !((bm >> n) & 1u); if (cand && dot[n] > best) { best = dot[n]; bi = n; } }
        if (bi >= 0) bm |= 1u << bi;
    }
    Flash f; flash_init(f);
    const bf16_t* Kg = (const bf16_t*)(R + R_KB) + slab; const bf16_t* Vg = (const bf16_t*)(R + R_VB) + slab;
    const int qp = qpos, qk4 = 4 * qblk;
    flash_loop(f, qf, Kg, Vg, SeqRange{0, 4 * qblk + 3}, [bm, qp, qk4](int j, bool& ok, int& klo, int& khi) {
        if (j < qk4) { ok = (bm >> (j >> 2)) & 1u; klo = 0; khi = 0x3ffffff; } else { ok = true; klo = 0; khi = qp; } }, lds, tid);
    const float sc = f.l > 0.f ? 1.0f / f.l : 0.f;
    bf16_t* ob = (bf16_t*)(R + R_OB) + (size_t)t * 512 + h * 64;
#pragma unroll
    for (int db = 0; db < 2; ++db)
#pragma unroll
        for (int a = 0; a < 4; ++a) { f32x4 v4 = {f.o[db][4 * a] * sc, f.o[db][4 * a + 1] * sc, f.o[db][4 * a + 2] * sc, f.o[db][4 * a + 3] * sc}; st_bf16x4(ob + 32 * db + 8 * a + 4 * hh, v4); }
}

static_assert(F8_M1 && F8_M2, "both layers' expert weights share the bf16-sized regions: fp8 only");
#ifndef MOBA_SPARSE
#define MOBA_SPARSE 1
#endif
static_assert(MOBA_SPARSE || !F8_P5, "the dense MoBA unit only writes the bf16 output");
constexpr size_t MO_LIST = O_H;
constexpr size_t MO_PO = MO_LIST + (size_t)1024 * 4096 * 4;
constexpr size_t MO_PML = MO_PO + (size_t)NT * 8 * 3 * 64 * 2;
static_assert(MO_PML + (size_t)NT * 8 * 3 * 2 * 4 <= O_R, "MoBA scratch does not fit in the H region");
DI unsigned* moba_cnt(const Params& p, int l) { return (unsigned*)(p.ws + O_MISC + 2048 + (size_t)l * 4096); }
DI unsigned moba_topk(const bf16x8 (&qf)[4], LAS const float* KM, int qblk, int hh) {
    float dot[16];
#pragma unroll
    for (int n = 0; n < 16; ++n) {
        float a = 0.f;
        if (n < qblk) {
#pragma unroll
            for (int ks = 0; ks < 4; ++ks) {
                const f32x4 k0 = *(LAS const f32x4*)(KM + n * 64 + 16 * ks + 8 * hh), k1 = *(LAS const f32x4*)(KM + n * 64 + 16 * ks + 8 * hh + 4);
#pragma unroll
                for (int j = 0; j < 4; ++j) { a += bf2f((unsigned short)qf[ks][j]) * k0[j]; a += bf2f((unsigned short)qf[ks][4 + j]) * k1[j]; }
            }
            a += shx(a, 32);
        }
        dot[n] = a;
    }
    unsigned bm = 0;
#pragma unroll
    for (int it = 0; it < 3; ++it) {
        float best = -INFINITY; int bi = -1;
#pragma unroll
        for (int n = 0; n < 16; ++n) { const bool cand = (n < qblk) && !((bm >> n) & 1u); if (cand && dot[n] > best) { best = dot[n]; bi = n; } }
        if (bi >= 0) bm |= 1u << bi;
    }
    return bm;
}
DI void moba_gate_unit(const Params& p, int l, int bh, int qblk, LAS char* lds, int tid) {
    char* R = p.ws + O_R;
    const int lane = tid & 63, w = tid >> 6, r = lane & 31, hh = lane >> 5;
    const int qpos = 256 * qblk + 32 * w + r;
    LAS float* KM = (LAS float*)(lds + 36864);
    LAS unsigned* wc = (LAS unsigned*)(lds + 36864 + 4096);
    LAS unsigned* lbase = wc + 128;
    __syncthreads();
    { const float* km = (const float*)(R + R_KMEAN) + (size_t)bh * 1024; KM[tid] = km[tid]; KM[tid + 512] = km[tid + 512]; }
    __syncthreads();
    bf16x8 qf[4]; load_qf(qf, (const bf16_t*)(R + R_QB) + ((size_t)bh * SEQ + qpos) * 64, hh);
    const unsigned bm = moba_topk(qf, KM, qblk, hh);
#pragma unroll
    for (int n = 0; n < 16; ++n) if (n < qblk) {
        const unsigned long long m64 = __ballot(((bm >> n) & 1u) && hh == 0);
        if (lane == 0) wc[n * 8 + w] = (unsigned)__builtin_popcountll(m64);
    }
    __syncthreads();
    if (tid < qblk) {
        unsigned tot = 0;
#pragma unroll
        for (int ww = 0; ww < 8; ++ww) { const unsigned cc = wc[tid * 8 + ww]; wc[tid * 8 + ww] = tot; tot += cc; }
        lbase[tid] = tot ? atomicAdd(moba_cnt(p, l) + bh * 16 + tid, tot) : 0u;
    }
    __syncthreads();
    unsigned* LIST = (unsigned*)(p.ws + MO_LIST);
#pragma unroll
    for (int n = 0; n < 16; ++n) if (n < qblk) {
        const bool sel = ((bm >> n) & 1u) && hh == 0;
        const unsigned long long m64 = __ballot(sel);
        if (sel) {
            const unsigned pos = lbase[n] + wc[n * 8 + w] + (unsigned)__builtin_popcountll(m64 & ((1ull << lane) - 1ull));
            LIST[(size_t)(bh * 16 + n) * 4096 + pos] = ((unsigned)qpos << 2) | (unsigned)__builtin_popcount(bm & ((1u << n) - 1u));
        }
    }
}
DI void moba_items(const Params& p, int l, LAS char* lds, int tid) {
    char* R = p.ws + O_R;
    const int lane = tid & 63, w = tid >> 6, r = lane & 31, hh = lane >> 5;
    LAS unsigned* pre = (LAS unsigned*)(lds + 40960);
    LAS unsigned* cnts = pre + 1024;
    const unsigned* MC = moba_cnt(p, l);
    __syncthreads();
    for (int i = tid; i < 1024; i += NTHREADS) { const unsigned cc = MC[i]; cnts[i] = cc; pre[i] = (cc + 255u) >> 8; }
    __syncthreads();
    if (tid < 64) {
        unsigned run = 0;
        for (int k = 0; k < 16; ++k) { run += pre[tid * 16 + k]; pre[tid * 16 + k] = run; }
        unsigned inc = run;
#pragma unroll
        for (int d = 1; d < 64; d <<= 1) { const unsigned o = __shfl_up(inc, d); if (lane >= d) inc += o; }
        const unsigned excl = inc - run;
        for (int k = 0; k < 16; ++k) pre[tid * 16 + k] += excl;
    }
    __syncthreads();
    const int T = (int)pre[1023];
    const unsigned* LIST = (const unsigned*)(p.ws + MO_LIST);
    bf16_t* PO = (bf16_t*)(p.ws + MO_PO); float* PML = (float*)(p.ws + MO_PML);
    for (int it = blockIdx.x; it < T; it += gridDim.x) {
        int lo = 0, hi = 1023;
        while (lo < hi) { const int mid = (lo + hi) >> 1; if (pre[mid] > (unsigned)it) hi = mid; else lo = mid + 1; }
        const int idx = lo, chunk = it - (idx ? (int)pre[idx - 1] : 0), bh = idx >> 4, n = idx & 15;
        const int e = 256 * chunk + 32 * w + r; const bool valid = e < (int)cnts[idx];
        const unsigned entry = valid ? LIST[(size_t)idx * 4096 + e] : 0u;
        const int s = (int)(entry >> 2), slot = (int)(entry & 3u);
        const size_t slab = (size_t)bh * SEQ * 64;
        bf16x8 qf[4]; load_qf(qf, (const bf16_t*)(R + R_QB) + slab + (size_t)s * 64, hh);
        Flash f; flash_init(f);
        const int vi = valid ? 1 : 0;
        flash_loop(f, qf, (const bf16_t*)(R + R_KB) + slab, (const bf16_t*)(R + R_VB) + slab, SeqRange{4 * n, 4 * n + 3},
                   [vi](int, bool& ok, int& klo, int& khi) { ok = vi != 0; klo = 0; khi = 0x3ffffff; }, lds, tid);
        if (valid) {
            const float inv = f.l > 0.f ? 1.0f / f.l : 0.f;
            const size_t pi = ((size_t)bh * SEQ + s) * 3 + slot;
            lane_o_store(PO + pi * 64, f.o, inv, hh);
            if (hh == 0) { f32x2 ml = {f.m, f.l}; *(f32x2*)(PML + pi * 2) = ml; }
        }
    }
}
DI void moba_own_unit(const Params& p, int b, int h, int qblk, LAS char* lds, int tid, int var, const bf16x8 (&qf)[4], FlPre* pre, FlNext nx) {
    char* R = p.ws + O_R;
    const int lane = tid & 63, w = tid >> 6, r = lane & 31, hh = lane >> 5;
    const int qpos = 256 * qblk + 32 * w + r, t = b * SEQ + qpos;
    const size_t slab = (size_t)(b * 8 + h) * SEQ * 64;
    Flash f; flash_init(f);
    const int qp = qpos;
    const int np = qblk < 3 ? qblk : 3;
    const bf16_t* PO = (const bf16_t*)(p.ws + MO_PO); const float* PML = (const float*)(p.ws + MO_PML);
    const size_t pi = ((size_t)(b * 8 + h) * SEQ + qpos) * 3;
    f32x2 mlr[3]; bf16x8 por[3][2][2];
#pragma unroll
    for (int k = 0; k < 3; ++k) {
        mlr[k] = (k < np) ? *(const f32x2*)(PML + (pi + k) * 2) : (f32x2){0.f, 0.f};
        lane_o_load(por[k], PO + (pi + k) * 64, hh, k < np);
    }
    if (var != 4) flash_loop(f, qf, (const bf16_t*)(R + R_KB) + slab, (const bf16_t*)(R + R_VB) + slab, SeqRange{(var == 2 && qblk > 0) ? 4 * qblk - 4 : ((var == 3 && qblk > 1) ? 4 * qblk - 8 : 4 * qblk), 4 * qblk + 3},
               [qp](int, bool& ok, int& klo, int& khi) { ok = true; klo = 0; khi = qp; }, lds, tid, pre, nx);
    float mk[3], lk[3], M = f.m;
#pragma unroll
    for (int k = 0; k < 3; ++k) { mk[k] = 0.f; lk[k] = 0.f; if (k < np) { mk[k] = mlr[k][0]; lk[k] = mlr[k][1]; M = fmaxf(M, mk[k]); } }
    const float w0 = fexp2(f.m - M);
    float den = f.l * w0;
#pragma unroll
    for (int i = 0; i < 16; ++i) { f.o[0][i] *= w0; f.o[1][i] *= w0; }
#pragma unroll
    for (int k = 0; k < 3; ++k) if (k < np) {
        const float wk = lk[k] * fexp2(mk[k] - M); den += wk;
#pragma unroll
        for (int db = 0; db < 2; ++db)
#pragma unroll
            for (int i = 0; i < 16; ++i) f.o[db][i] += wk * bf2f((unsigned short)por[k][db][i >> 3][i & 7]);
    }
    const float sc = den > 0.f ? 1.0f / den : 0.f;
    bf16_t* ob = (bf16_t*)(R + R_OB) + (size_t)t * 512 + h * 64;
#pragma unroll
    for (int db = 0; db < 2; ++db)
#pragma unroll
        for (int a = 0; a < 4; ++a) { f32x4 v4 = {f.o[db][4 * a] * sc, f.o[db][4 * a + 1] * sc, f.o[db][4 * a + 2] * sc, f.o[db][4 * a + 3] * sc};
            if (F8_P5) *(unsigned*)((unsigned char*)(p.ws + O_OB8) + (size_t)t * 512 + h * 64 + 32 * db + 8 * a + 4 * hh) = pk4_fp8(v4[0] * OS8, v4[1] * OS8, v4[2] * OS8, v4[3] * OS8);
            else st_bf16x4(ob + 32 * db + 8 * a + 4 * hh, v4); }
}
DI void phase_moba_own(const Params& p, LAS char* lds, int var) {
    char* R = p.ws + O_R;
    const int tid = opaque_tid(), lane = tid & 63, w = tid >> 6, r = lane & 31, hh = lane >> 5, G = gridDim.x;
    FlPre pre; pre.has = false; pre.k = (u32x4){0u, 0u, 0u, 0u}; pre.v = pre.k;
    bf16x8 qn[4];
    int u = blockIdx.x;
    if (u < 1024) load_qf(qn, (const bf16_t*)(R + R_QB) + ((size_t)(u & 63) * SEQ + 256 * (u >> 6) + 32 * w + r) * 64, hh);
    for (; u < 1024; u += G) {
        bf16x8 qf[4];
#pragma unroll
        for (int i = 0; i < 4; ++i) qf[i] = qn[i];
        const int un = u + G; FlNext nx{nullptr, nullptr, -1};
        if (un < 1024) {
            const size_t slabn = (size_t)(un & 63) * SEQ * 64;
            if (var == 0) nx = FlNext{(const bf16_t*)(R + R_KB) + slabn, (const bf16_t*)(R + R_VB) + slabn, 4 * (un >> 6)};
            load_qf(qn, (const bf16_t*)(R + R_QB) + slabn + (size_t)(256 * (un >> 6) + 32 * w + r) * 64, hh);
        }
        moba_own_unit(p, (u & 63) >> 3, u & 7, u >> 6, lds, tid, var, qf, &pre, nx);
    }
}
DI void phase_attention(const Params& p, int l, LAS char* lds, int which = 3) {
    const int tid = opaque_tid(), G = gridDim.x, c = blockIdx.x;
    if (which & 1) for (int rnd = 0; rnd * G < 1024; ++rnd) {
        const int i = rnd * G + ((rnd & 1) ? G - 1 - c : c);
        if (i < 1024) { const int qb = 63 - (i >> 4), bg = i & 15; nsa_unit(p, bg >> 1, bg & 1, qb, lds, tid); }
    }
#if MOBA_SPARSE
    if (which & 2) moba_items(p, l, lds, tid);
#else
    if (which & 2) for (int rnd = 0; rnd * G < 1024; ++rnd) {
        const int i = rnd * G + ((rnd & 1) ? G - 1 - c : c);
        if (i < 1024) { const int qblk = 15 - (i >> 6), bh = i & 63; moba_unit(p, bh >> 3, bh & 7, qblk, lds, tid); }
    }
#endif
}

DI void phase_projab(const Params& p, int l, LAS char* lds) {
    const int tid = opaque_tid(), lane = tid & 63, wid = tid >> 6, wm = wid >> 1, wn = wid & 1, fr = lane & 15, fq = lane >> 4;
    int R0, C0; thread_rc(tid, R0, C0);
    char* R = p.ws + O_R;
    const bf16_t* OA = (const bf16_t*)(R + R_OA); const bf16_t* OB = (const bf16_t*)(R + R_OB);
    const bf16_t* WA = (const bf16_t*)(p.ws + O_WPA) + (size_t)l * D * 512; const bf16_t* WB = (const bf16_t*)(p.ws + O_WPB) + (size_t)l * D * 512;
    const bf16_t* MA = (const bf16_t*)(R + R_MA); const bf16_t* MB = (const bf16_t*)(R + R_MB); bf16_t* MG = (bf16_t*)(R + R_MERGED);
    for (int u = blockIdx.x; u < 128 * 8; u += gridDim.x) {
        const int rt = u >> 3, ct = u & 7;
        const bf16_t* ap[4]; const bf16_t* bp[2];
        f32x4 acc[4][4], acc2[4][4]; zero_acc(acc); zero_acc(acc2);
#pragma unroll
        for (int i = 0; i < 4; ++i) ap[i] = OA + (size_t)(rt * 256 + R0 + 64 * i) * 512 + C0;
#pragma unroll
        for (int i = 0; i < 2; ++i) bp[i] = WA + (size_t)(ct * 128 + R0 + 64 * i) * 512 + C0;
        gemm_kloop<4, 2>(acc, ap, bp, 8, lds, tid);
#pragma unroll
        for (int i = 0; i < 4; ++i) ap[i] = OB + (size_t)(rt * 256 + R0 + 64 * i) * 512 + C0;
#pragma unroll
        for (int i = 0; i < 2; ++i) bp[i] = WB + (size_t)(ct * 128 + R0 + 64 * i) * 512 + C0;
        gemm_kloop<4, 2>(acc2, ap, bp, 8, lds, tid);
#pragma unroll
        for (int m = 0; m < 4; ++m) {
            const size_t o = (size_t)(rt * 256 + wm * 64 + 16 * m + fr) * D + ct * 128 + wn * 64 + 4 * fq;
#pragma unroll
            for (int n = 0; n < 4; ++n) {
                const s16x4 ma = *(const s16x4*)(MA + o + 16 * n), mb = *(const s16x4*)(MB + o + 16 * n);
                f32x4 v;
#pragma unroll
                for (int q = 0; q < 4; ++q) v[q] = bf2f((unsigned short)ma[q]) * acc[m][n][q] + bf2f((unsigned short)mb[q]) * acc2[m][n][q];
                st_bf16x4(MG + o + 16 * n, v);
            }
        }
    }
}
DI void phase_wout(const Params& p, int l, LAS char* lds) {
    const int tid = opaque_tid(), lane = tid & 63, wid = tid >> 6, wm = wid >> 1, wn = wid & 1, fr = lane & 15, fq = lane >> 4;
    int R0, C0; thread_rc(tid, R0, C0);
    char* R = p.ws + O_R;
    const bf16_t* A = (const bf16_t*)(R + R_MERGED); const bf16_t* Bt = (const bf16_t*)(p.ws + O_WOUT) + (size_t)l * D * D;
    const float* xin = (l == 0) ? p.in[I_X] : (const float*)(p.ws + O_XF2); float* Y = (float*)(R + R_YPRE);
    for (int u = blockIdx.x; u < 128 * 8; u += gridDim.x) {
        const int rt = u >> 3, ct = u & 7;
        const bf16_t* ap[4]; const bf16_t* bp[2];
#pragma unroll
        for (int i = 0; i < 4; ++i) ap[i] = A + (size_t)(rt * 256 + R0 + 64 * i) * D + C0;
#pragma unroll
        for (int i = 0; i < 2; ++i) bp[i] = Bt + (size_t)(ct * 128 + R0 + 64 * i) * D + C0;
        f32x4 acc[4][4]; zero_acc(acc);
        gemm_kloop<4, 2>(acc, ap, bp, D / 64, lds, tid);
#pragma unroll
        for (int m = 0; m < 4; ++m) {
            const size_t o = (size_t)(rt * 256 + wm * 64 + 16 * m + fr) * D + ct * 128 + wn * 64 + 4 * fq;
#pragma unroll
            for (int n = 0; n < 4; ++n) { const f32x4 xv = *(const f32x4*)(xin + o + 16 * n); *(f32x4*)(Y + o + 16 * n) = xv * ALPHA + acc[m][n]; }
        }
    }
}
DI void ln_row_store(float (&v)[16], const float* g, const float* bta, float* outf, bf16_t* outb, int lane, unsigned char* out8 = nullptr) {
    float s = 0.f;
#pragma unroll
    for (int i = 0; i < 16; ++i) s += v[i];
#pragma unroll
    for (int m = 1; m < 64; m <<= 1) s += shx(s, m);
    const float mean = s * (1.0f / 1024.0f);
    float q = 0.f;
#pragma unroll
    for (int i = 0; i < 16; ++i) { const float d = v[i] - mean; q += d * d; }
#pragma unroll
    for (int m = 1; m < 64; m <<= 1) q += shx(q, m);
    const float rstd = rsqrtf(q * (1.0f / 1024.0f) + LN_EPS);
#pragma unroll
    for (int hlf = 0; hlf < 2; ++hlf) {
        const int c0 = hlf * 512 + 8 * lane;
        const f32x4 g0 = *(const f32x4*)(g + c0), g1 = *(const f32x4*)(g + c0 + 4), b0 = *(const f32x4*)(bta + c0), b1 = *(const f32x4*)(bta + c0 + 4);
        f32x4 y0, y1;
#pragma unroll
        for (int j = 0; j < 4; ++j) { y0[j] = (v[hlf * 8 + j] - mean) * rstd * g0[j] + b0[j]; y1[j] = (v[hlf * 8 + 4 + j] - mean) * rstd * g1[j] + b1[j]; }
        if (outf) { *(f32x4*)(outf + c0) = y0; *(f32x4*)(outf + c0 + 4) = y1; }
        if (outb) { u32x4 wv; wv.x = pk2(y0[0], y0[1]); wv.y = pk2(y0[2], y0[3]); wv.z = pk2(y1[0], y1[1]); wv.w = pk2(y1[2], y1[3]); *(u32x4*)(outb + c0) = wv; }
        if (out8) { u32x2 w8; w8.x = pk4_fp8(y0[0] * XS8, y0[1] * XS8, y0[2] * XS8, y0[3] * XS8); w8.y = pk4_fp8(y1[0] * XS8, y1[1] * XS8, y1[2] * XS8, y1[3] * XS8); *(u32x2*)(out8 + c0) = w8; }
    }
}
DI void phase_ln1(const Params& p, int l) {
    const int tid = opaque_tid(), lane = tid & 63, gw = blockIdx.x * 8 + (tid >> 6), nw = gridDim.x * 8;
    const bf16_t* Y = (const bf16_t*)(p.ws + O_R + R_YPRE); bf16_t* XB = (bf16_t*)(p.ws + O_XB1);
    const float* g = p.in[I_LN1G] + (size_t)l * D; const float* bta = p.in[I_LN1B] + (size_t)l * D;
    for (int row = gw; row < NT; row += nw) {
        float v[16];
#pragma unroll
        for (int hlf = 0; hlf < 2; ++hlf) { const bf16x8 a = *(const bf16x8*)(Y + (size_t)row * D + hlf * 512 + 8 * lane);
#pragma unroll
            for (int j = 0; j < 8; ++j) v[hlf * 8 + j] = bf2f((unsigned short)a[j]); }
        ln_row_store(v, g, bta, nullptr, XB + (size_t)row * D, lane, F8_M1 ? (unsigned char*)(p.ws + O_XA8) + (size_t)row * D : nullptr);
    }
    int* rt = (int*)(p.ws + O_ROWTOK);
    for (size_t i = (size_t)blockIdx.x * NTHREADS + tid; i < (size_t)MAXROWS + 256; i += (size_t)gridDim.x * NTHREADS) rt[i] = 0;
}
DI void phase_router(const Params& p, int l, LAS char* lds) {
    const int tid = opaque_tid(), lane = tid & 63, wid = tid >> 6, wm = wid >> 1, wn = wid & 1, fr = lane & 15, fq = lane >> 4;
    int R0, C0; thread_rc(tid, R0, C0);
    const bf16_t* A = (const bf16_t*)(p.ws + O_XB1); const bf16_t* Bt = (const bf16_t*)(p.ws + O_WR) + (size_t)l * NE * D; float* LG = (float*)(p.ws + O_LOGIT);
    for (int u = blockIdx.x; u < 128 * 2; u += gridDim.x) {
        const int rt = u >> 1, ct = u & 1;
        const bf16_t* ap[4]; const bf16_t* bp[2];
#pragma unroll
        for (int i = 0; i < 4; ++i) ap[i] = A + (size_t)(rt * 256 + R0 + 64 * i) * D + C0;
#pragma unroll
        for (int i = 0; i < 2; ++i) bp[i] = Bt + (size_t)(ct * 128 + R0 + 64 * i) * D + C0;
        f32x4 acc[4][4]; zero_acc(acc);
        gemm_kloop<4, 2>(acc, ap, bp, D / 64, lds, tid);
#pragma unroll
        for (int m = 0; m < 4; ++m) {
            const size_t o = (size_t)(rt * 256 + wm * 64 + 16 * m + fr) * NE + ct * 128 + wn * 64 + 4 * fq;
#pragma unroll
            for (int n = 0; n < 4; ++n) *(f32x4*)(LG + o + 16 * n) = acc[m][n];
        }
    }
}
DI void phase_routing(const Params& p, int l, LAS char* lds, int var = 0) {
    const int tid = opaque_tid(), lane = tid & 63, w = tid >> 6;
    LAS unsigned* hist = (LAS unsigned*)lds; LAS unsigned* base = hist + 256; LAS unsigned* loc = hist + 512; LAS float* biasL = (LAS float*)(hist + 1536);
    const float* LG = (const float*)(p.ws + O_LOGIT); const float* rb = p.in[I_RB] + (size_t)l * NE;
    int* TOPI = (int*)(p.ws + O_TOPI); float* GATE = (float*)(p.ws + O_GATE); int* POS = (int*)(p.ws + O_POS);
    unsigned* CNT = (unsigned*)(p.ws + O_CNT) + l * NE;
    for (int tb = blockIdx.x; tb < NT / 128; tb += gridDim.x) {
    __syncthreads();
    if (tid < 256) { hist[tid] = 0u; biasL[tid] = rb[tid]; }
    __syncthreads();
    if (w < 2) {
        const int t = tb * 128 + w * 64 + lane;
        const float* row = LG + (size_t)t * NE;
        float gs[8];
#pragma unroll
        for (int g = 0; g < 8; ++g) {
            float a1 = -INFINITY, a2 = -INFINITY;
#pragma unroll
            for (int j4 = 0; j4 < 8; ++j4) {
                const f32x4 lg = *(const f32x4*)(row + g * 32 + j4 * 4); const f32x4 bb = *(LAS const f32x4*)(biasL + g * 32 + j4 * 4);
#pragma unroll
                for (int q = 0; q < 4; ++q) { const float v = frcp(1.0f + __expf(-lg[q])) + bb[q]; const float n1 = fmaxf(a1, v), n2 = fmaxf(a2, fminf(a1, v)); a1 = n1; a2 = n2; }
            }
            gs[g] = a1 + a2;
        }
        int sel[8], pos[8];
#pragma unroll
        for (int g = 0; g < 8; ++g) { int rk = 0;
#pragma unroll
            for (int g2 = 0; g2 < 8; ++g2) rk += (g2 != g && (gs[g2] > gs[g] || (gs[g2] == gs[g] && g2 < g))) ? 1 : 0;
            sel[g] = rk < 4; }
        { int c = 0;
#pragma unroll
          for (int g = 0; g < 8; ++g) { pos[g] = c; c += sel[g]; } }
        float lv[8]; int li[8];
#pragma unroll
        for (int k = 0; k < 8; ++k) { lv[k] = -INFINITY; li[k] = 0; }
#pragma unroll
        for (int k = 0; k < 4; ++k) {
            int g = 0;
#pragma unroll
            for (int g2 = 0; g2 < 8; ++g2) g = (sel[g2] && pos[g2] == k) ? g2 : g;
#pragma unroll
            for (int j4 = 0; j4 < 8; ++j4) {
                const f32x4 lg = *(const f32x4*)(row + g * 32 + j4 * 4); const f32x4 bb = *(LAS const f32x4*)(biasL + g * 32 + j4 * 4);
#pragma unroll
                for (int q = 0; q < 4; ++q) {
                    float v = frcp(1.0f + __expf(-lg[q])) + bb[q]; int e = g * 32 + j4 * 4 + q;
                    if (v > lv[7]) {
                        lv[7] = v; li[7] = e;
#pragma unroll
                        for (int k2 = 7; k2 > 0; --k2) { const bool sw = lv[k2] > lv[k2 - 1]; const float tv = lv[k2]; const int ti = li[k2];
                            lv[k2] = sw ? lv[k2 - 1] : lv[k2]; li[k2] = sw ? li[k2 - 1] : li[k2]; lv[k2 - 1] = sw ? tv : lv[k2 - 1]; li[k2 - 1] = sw ? ti : li[k2 - 1]; }
                    }
                }
            }
        }
        float sc8[8], ssum = 0.f;
#pragma unroll
        for (int k = 0; k < 8; ++k) { sc8[k] = lv[k] - biasL[li[k]]; ssum += sc8[k]; }
        const float rs = 2.5f * frcp(ssum);
        int* ti = TOPI + (size_t)t * 8; float* gt = GATE + (size_t)t * 8;
#pragma unroll
        for (int k = 0; k < 8; ++k) { ti[k] = li[k]; gt[k] = sc8[k] * rs; }
        if (var != 1) {
#pragma unroll
            for (int k = 0; k < 8; ++k) { const unsigned rk = __hip_atomic_fetch_add(&hist[li[k]], 1u, __ATOMIC_RELAXED, __HIP_MEMORY_SCOPE_WORKGROUP); loc[(w * 64 + lane) * 8 + k] = ((unsigned)li[k] << 16) | rk; }
        }
    }
    __syncthreads();
    if (var != 1) {
    if (tid < 256) { const unsigned c = hist[tid]; base[tid] = c ? atomicAdd(&CNT[tid], c) : 0u; }
    __syncthreads();
    for (int i = tid; i < 1024; i += NTHREADS) { const unsigned v = loc[i]; POS[tb * 1024 + i] = (int)(base[v >> 16] + (v & 0xffffu)); }
    }
    }
}
DI void phase_dispatch(const Params& p, int l, LAS char* lds) {
    const int tid = opaque_tid();
    LAS int* sc = (LAS int*)lds;
    const unsigned* CNT = (const unsigned*)(p.ws + O_CNT) + l * NE;
    int pad = 0;
    __syncthreads();
    if (tid < NE) { pad = ((int)CNT[tid] + 127) & ~127; sc[tid] = pad; }
    __syncthreads();
    for (int d = 1; d < NE; d <<= 1) {
        int v = 0;
        if (tid < NE && tid >= d) v = sc[tid - d];
        __syncthreads();
        if (tid < NE) sc[tid] += v;
        __syncthreads();
    }
    if (blockIdx.x == 0) {
        int* TE = (int*)(p.ws + O_TILEE);
        if (tid < NE) { const int pe = sc[tid], ps = pe - pad; for (int r = ps; r < pe; r += 128) TE[r >> 7] = tid; if (tid == NE - 1) ((int*)(p.ws + O_MISC))[l] = pe >> 7; }
    }
    const int* TOPI = (const int*)(p.ws + O_TOPI); const int* POS = (const int*)(p.ws + O_POS); int* SLOT = (int*)(p.ws + O_SLOT); int* RT = (int*)(p.ws + O_ROWTOK);
    for (size_t a = (size_t)blockIdx.x * NTHREADS + tid; a < (size_t)NT * TOPK; a += (size_t)gridDim.x * NTHREADS) {
        const int e = TOPI[a]; const int ps = (e > 0) ? sc[e - 1] : 0;
        const int dest = ps + POS[a];
        RT[dest] = (int)(a >> 3); SLOT[a] = dest;
    }
}
DI void phase_moe1(const Params& p, int l, LAS char* lds) {
    const int tid = opaque_tid(), lane = tid & 63, wid = tid >> 6, wm = wid >> 2, wn = wid & 3, fr = lane & 15, fq = lane >> 4;
    int R0, C0; thread_rc(tid, R0, C0);
    const int ntr = ((const int*)(p.ws + O_MISC))[l];
    const int* RT = (const int*)(p.ws + O_ROWTOK); const int* TE = (const int*)(p.ws + O_TILEE);
    const bf16_t* X = (const bf16_t*)(p.ws + O_XB1); bf16_t* H = (bf16_t*)(p.ws + O_H);
    const bf16_t* WGU = (const bf16_t*)(p.ws + O_WGU); const bf16_t* WS = (const bf16_t*)(p.ws + O_WSGU) + (size_t)l * 512 * D;
    for (int u = blockIdx.x; u < (ntr + 256) * 2; u += gridDim.x) {
        const int ti = u >> 1, ct = u & 1;
        const bool routed = ti < ntr;
        const int hrow0 = routed ? ti * 128 : MAXROWS + (ti - ntr) * 128;
        const bf16_t* W = routed ? WGU + (size_t)TE[ti] * 512 * D : WS;
        const bf16_t* ap[2]; const bf16_t* bp[4];
#pragma unroll
        for (int i = 0; i < 2; ++i) { const int rr = R0 + 64 * i; const int tok = routed ? RT[ti * 128 + rr] : (ti - ntr) * 128 + rr; ap[i] = X + (size_t)tok * D + C0; }
#pragma unroll
        for (int i = 0; i < 4; ++i) bp[i] = W + (size_t)(ct * 256 + R0 + 64 * i) * D + C0;
        f32x4 acc[4][4]; zero_acc(acc);
        gemm_kloop<2, 4>(acc, ap, bp, D / 64, lds, tid);
#pragma unroll
        for (int m = 0; m < 4; ++m) {
            bf16_t* hr = H + (size_t)(hrow0 + wm * 64 + 16 * m + fr) * DE + ct * 128 + wn * 32 + 4 * fq;
#pragma unroll
            for (int jn = 0; jn < 2; ++jn) {
                const f32x4 gv = acc[m][2 * jn], uv = acc[m][2 * jn + 1]; f32x4 hv;
#pragma unroll
                for (int q = 0; q < 4; ++q) hv[q] = gv[q] * frcp(1.0f + __expf(-gv[q])) * uv[q];
                st_bf16x4(hr + 16 * jn, hv);
            }
        }
    }
}
DI void phase_moe2(const Params& p, int l, LAS char* lds) {
    const int tid = opaque_tid(), lane = tid & 63, wid = tid >> 6, wm = wid >> 2, wn = wid & 3, fr = lane & 15, fq = lane >> 4;
    int R0, C0; thread_rc(tid, R0, C0);
    const int ntr = ((const int*)(p.ws + O_MISC))[l];
    const int* TE = (const int*)(p.ws + O_TILEE);
    const bf16_t* H = (const bf16_t*)(p.ws + O_H); bf16_t* Y = (bf16_t*)(p.ws + O_R);
    const bf16_t* WDN = (const bf16_t*)(p.ws + O_WDN); const bf16_t* WS = (const bf16_t*)(p.ws + O_WSD) + (size_t)l * D * DE;
    for (int u = blockIdx.x; u < (ntr + 256) * 4; u += gridDim.x) {
        const int ti = u >> 2, ct = u & 3;
        const bool routed = ti < ntr;
        const int hrow0 = routed ? ti * 128 : MAXROWS + (ti - ntr) * 128;
        const bf16_t* W = routed ? WDN + (size_t)TE[ti] * D * DE : WS;
        const bf16_t* ap[2]; const bf16_t* bp[4];
#pragma unroll
        for (int i = 0; i < 2; ++i) ap[i] = H + (size_t)(hrow0 + R0 + 64 * i) * DE + C0;
#pragma unroll
        for (int i = 0; i < 4; ++i) bp[i] = W + (size_t)(ct * 256 + R0 + 64 * i) * DE + C0;
        f32x4 acc[4][4]; zero_acc(acc);
        gemm_kloop<2, 4>(acc, ap, bp, DE / 64, lds, tid);
#pragma unroll
        for (int m = 0; m < 4; ++m) {
            bf16_t* yr = Y + (size_t)(hrow0 + wm * 64 + 16 * m + fr) * D + ct * 256 + wn * 64 + 4 * fq;
#pragma unroll
            for (int n = 0; n < 4; ++n) st_bf16x4(yr + 16 * n, acc[m][n]);
        }
    }
}
DI void phase_combine(const Params& p, int l, int var = 0) {
    const int tid = opaque_tid(), lane = tid & 63, gw = blockIdx.x * 8 + (tid >> 6), nw = gridDim.x * 8;
    const unsigned char* Y = (const unsigned char*)(p.ws + O_R); const bf16_t* X1 = (const bf16_t*)(p.ws + O_XB1);
    const int* SLOT = (const int*)(p.ws + O_SLOT); const float* GATE = (const float*)(p.ws + O_GATE);
    const float* g = p.in[I_LN2G] + (size_t)l * D; const float* bta = p.in[I_LN2B] + (size_t)l * D;
    float* outf = (l == NL - 1) ? p.out : nullptr; bf16_t* outb = (l == NL - 1) ? nullptr : (bf16_t*)(p.ws + (var == 1 ? O_XB0 : O_XB1));
    for (int t0 = gw * 2; t0 < NT; t0 += nw * 2) {
        float v[2][16]; int slot[2]; float gt[2];
#pragma unroll
        for (int u = 0; u < 2; ++u) {
            const int t = t0 + u;
            slot[u] = 0; gt[u] = 0.f;
            if (lane < 8) { slot[u] = SLOT[t * 8 + lane]; gt[u] = GATE[t * 8 + lane]; }
#pragma unroll
            for (int hlf = 0; hlf < 2; ++hlf) { const bf16x8 a = *(const bf16x8*)(X1 + (size_t)t * D + hlf * 512 + 8 * lane);
#pragma unroll
                for (int j = 0; j < 8; ++j) v[u][hlf * 8 + j] = bf2f((unsigned short)a[j]) * ALPHA; }
        }
#pragma unroll
        for (int k = 0; k < 9; ++k) {
#pragma unroll
            for (int u = 0; u < 2; ++u) {
                const int t = t0 + u;
                const int row = (k < 8) ? __shfl(slot[u], k) : MAXROWS + t; const float gk = ((k < 8) ? __shfl(gt[u], k) : 1.0f) * (1.0f / 16.0f);
#pragma unroll
                for (int hlf = 0; hlf < 2; ++hlf) { const u32x2 yv = *(const u32x2*)(Y + (size_t)row * D + hlf * 512 + 8 * lane);
                    const f32x2 a0 = __builtin_amdgcn_cvt_pk_f32_fp8((int)yv.x, false), a1 = __builtin_amdgcn_cvt_pk_f32_fp8((int)yv.x, true);
                    const f32x2 a2 = __builtin_amdgcn_cvt_pk_f32_fp8((int)yv.y, false), a3 = __builtin_amdgcn_cvt_pk_f32_fp8((int)yv.y, true);
                    v[u][hlf * 8 + 0] += gk * a0.x; v[u][hlf * 8 + 1] += gk * a0.y; v[u][hlf * 8 + 2] += gk * a1.x; v[u][hlf * 8 + 3] += gk * a1.y;
                    v[u][hlf * 8 + 4] += gk * a2.x; v[u][hlf * 8 + 5] += gk * a2.y; v[u][hlf * 8 + 6] += gk * a3.x; v[u][hlf * 8 + 7] += gk * a3.y; }
            }
        }
#pragma unroll
        for (int u = 0; u < 2; ++u) { const int t = t0 + u; ln_row_store(v[u], g, bta, outf ? outf + (size_t)t * D : nullptr, outb ? outb + (size_t)t * D : nullptr, lane, (F8_P1 && outb) ? (unsigned char*)(p.ws + O_XA8) + (size_t)t * D : nullptr); }
    }
}

DI int lds_byte(int r, int c) { const int st = (r >> 4) * 2 + (c >> 5), rr = r & 15, cc = c & 31, ob = rr * 64 + cc * 2; return st * 1024 + (ob ^ (((ob >> 9) & 1) << 5)); }
struct GUnit { unsigned A, B; int pm, pn, x0, x1; };
DI int xcd_remap(int L, int nwg) { const int q = nwg >> 3, r = nwg & 7, xcd = L & 7, off = L >> 3; return (xcd < r ? xcd * (q + 1) : r * (q + 1) + (xcd - r) * q) + off; }
constexpr int HTB = 16384;

template <bool F8> DI f32x4 g8_mfma(const bf16x8 (&b)[2], const bf16x8 (&a)[2], f32x4 c) {
    if constexpr (F8) {
        const i32x8 a8 = __builtin_shufflevector(__builtin_bit_cast(i32x4, a[0]), __builtin_bit_cast(i32x4, a[1]), 0, 1, 2, 3, 4, 5, 6, 7);
        const i32x8 b8 = __builtin_shufflevector(__builtin_bit_cast(i32x4, b[0]), __builtin_bit_cast(i32x4, b[1]), 0, 1, 2, 3, 4, 5, 6, 7);
        return __builtin_amdgcn_mfma_scale_f32_16x16x128_f8f6f4(b8, a8, c, 0, 0, 0, 0, 0, 0);
    } else {
        c = __builtin_amdgcn_mfma_f32_16x16x32_bf16(b[0], a[0], c, 0, 0, 0);
        return __builtin_amdgcn_mfma_f32_16x16x32_bf16(b[1], a[1], c, 0, 0, 0);
    }
}
template <bool F8, class Sched, class Epi>
DI void gemm8(LAS char* lds, const char* wsbase, const int K, const Sched& S, const Epi& E, const int tid) {
    const int wid = __builtin_amdgcn_readfirstlane(tid >> 6), lane = tid & 63, wr = wid >> 2, wc = wid & 3, fr = lane & 15, fq = lane >> 4;
    const int nt = K / 64;
    const __amdgpu_buffer_rsrc_t rs = __builtin_amdgcn_make_buffer_rsrc((void*)wsbase, 0, 0xffffffffu, 0x00020000);
    unsigned voffB0;
    { int Rr, Cc; stage_rc(tid * 16, Rr, Cc); const int rho = Rr & 31, Rb = (Rr & ~31) + 8 * ((rho & 15) >> 2) + 4 * (rho >> 4) + (rho & 3);
        voffB0 = (unsigned)(Rb * K + Cc) * 2u; }
    const unsigned rstep64 = 128u * (unsigned)K;
    constexpr bool GA = Sched::kGather;
    unsigned oA0 = 0u;
    if constexpr (!GA) { int Rr, Cc; stage_rc(tid * 16, Rr, Cc); oA0 = (unsigned)(Rr * K + Cc) * 2u; }
    const unsigned kstep = 128u, hstepB = 128u * (unsigned)K * 2u;
    const unsigned ldsw = (unsigned)wid * 1024u;
    const int aoff = lds_byte(wr * 64 + fr, fq * 8), boff = lds_byte(wc * 32 + fr, fq * 8);
#define G8_SA(b, h) (((b) * 2 + (h)) * HTB)
#define G8_SB(b, h) ((4 + (b) * 2 + (h)) * HTB)
#define G8_STAGE(bufoff, s0, s1, o0, o1) do { \
        __builtin_amdgcn_raw_ptr_buffer_load_lds(rs, (LAS void*)(lds + (bufoff) + ldsw), 16, (int)(o0), (int)(s0), 0, 0); \
        __builtin_amdgcn_raw_ptr_buffer_load_lds(rs, (LAS void*)(lds + (bufoff) + ldsw + 8192), 16, (int)(o1), (int)(s1), 0, 0); } while (0)
#define G8_STAGEB(bufoff, sbase) G8_STAGE(bufoff, sbase, (sbase) + rstep64, voffB0, voffB0)
#define G8_STAGEA(bufoff, sbase, h, q0, q1) do { if constexpr (GA) G8_STAGE(bufoff, sbase, sbase, q0, q1); \
        else G8_STAGE(bufoff, (sbase) + (h) * 2u * rstep64, (sbase) + (h) * 2u * rstep64 + rstep64, oA0, oA0); } while (0)
#define G8_LDA(dst, b, h) do { _Pragma("unroll") for (int m = 0; m < 4; ++m) _Pragma("unroll") for (int k = 0; k < 2; ++k) dst[m][k] = *(const LAS bf16x8*)(lds + G8_SA(b, h) + aoff + m * 2048 + k * 1024); } while (0)
#define G8_LDB(dst, b, h) do { _Pragma("unroll") for (int n = 0; n < 2; ++n) _Pragma("unroll") for (int k = 0; k < 2; ++k) dst[n][k] = *(const LAS bf16x8*)(lds + G8_SB(b, h) + boff + n * 2048 + k * 1024); } while (0)
#define G8_MMA(ai, bj, At, Bt) do { __builtin_amdgcn_s_setprio(1); _Pragma("unroll") for (int m = 0; m < 4; ++m) _Pragma("unroll") for (int n = 0; n < 2; ++n) \
        acc[ai][bj][m][n] = g8_mfma<F8>(Bt[n], At[m], acc[ai][bj][m][n]); __builtin_amdgcn_s_setprio(0); } while (0)
#define G8_WAIT_V(n) asm volatile("s_waitcnt vmcnt(" #n ")" ::: "memory")
#define G8_WAIT_L(n) asm volatile("s_waitcnt lgkmcnt(" #n ")" ::: "memory")
#define G8_BAR __builtin_amdgcn_s_barrier()
#define G8_SCHED __builtin_amdgcn_sched_barrier(0)
    GUnit cur, nxt; int ui = 0;
    if (!S.next(0, cur)) return;
    unsigned oA[2][2], nA_[2][2];
    if constexpr (GA) S.aoffs(cur, tid, K, oA);
    else {
#pragma unroll
        for (int h = 0; h < 2; ++h)
#pragma unroll
            for (int i = 0; i < 2; ++i) { oA[h][i] = 0u; nA_[h][i] = 0u; }
    }
    f32x4 acc[2][2][4][2];
#pragma unroll
    for (int a = 0; a < 2; ++a)
#pragma unroll
        for (int b = 0; b < 2; ++b)
#pragma unroll
            for (int m = 0; m < 4; ++m)
#pragma unroll
                for (int n = 0; n < 2; ++n) acc[a][b][m][n] = (f32x4){0.f, 0.f, 0.f, 0.f};
    bf16x8 At[4][2], B0[2][2], B1[2][2];
    unsigned cA = cur.A, cB = cur.B;
    G8_STAGEB(G8_SB(0, 0), cB); G8_STAGEB(G8_SB(0, 1), cB + hstepB); G8_STAGEA(G8_SA(0, 0), cA, 0, oA[0][0], oA[0][1]); G8_STAGEA(G8_SA(0, 1), cA, 1, oA[1][0], oA[1][1]);
    if (wr == 1) G8_BAR;
    G8_WAIT_V(2); G8_BAR;
    G8_STAGEB(G8_SB(1, 0), cB + kstep); G8_STAGEA(G8_SA(1, 0), cA + kstep, 0, oA[0][0], oA[0][1]); G8_STAGEB(G8_SB(1, 1), cB + hstepB + kstep);
    G8_WAIT_V(6); G8_BAR;
    for (;;) {
        const bool has_next = S.next(ui + 1, nxt);
        const unsigned nA = has_next ? nxt.A : cA, nB = has_next ? nxt.B : cB;
        if constexpr (!GA) {}
        else if (has_next) S.aoffs(nxt, tid, K, nA_);
        else {
#pragma unroll
            for (int h = 0; h < 2; ++h)
#pragma unroll
                for (int i = 0; i < 2; ++i) nA_[h][i] = oA[h][i];
        }
        const bool hi = cur.x1 != 1;
#pragma unroll 1
        for (int t = 0; t < nt; t += 2) {
            const bool last = (t == nt - 2);
            const unsigned a1 = cA + (unsigned)(t + 1) * kstep;
            const unsigned a2 = last ? nA : cA + (unsigned)(t + 2) * kstep, b2 = last ? nB : cB + (unsigned)(t + 2) * kstep;
            const unsigned a3 = a2 + kstep, b3 = b2 + kstep;
            const unsigned p00 = last ? nA_[0][0] : oA[0][0], p01 = last ? nA_[0][1] : oA[0][1], p10 = last ? nA_[1][0] : oA[1][0], p11 = last ? nA_[1][1] : oA[1][1];
            G8_LDB(B0, 0, 0); G8_LDB(B1, 0, 1); G8_SCHED; G8_LDA(At, 0, 0); G8_STAGEA(G8_SA(1, 1), a1, 1, oA[1][0], oA[1][1]);
            G8_WAIT_V(8); G8_WAIT_L(0); G8_BAR; G8_MMA(0, 0, At, B0); G8_MMA(0, 1, At, B1); G8_BAR; G8_SCHED;
            G8_LDA(At, 0, 1); G8_STAGEB(G8_SB(0, 0), b2); G8_STAGEB(G8_SB(0, 1), b2 + hstepB); G8_STAGEA(G8_SA(0, 0), a2, 0, p00, p01);
            G8_WAIT_V(8); G8_WAIT_L(0); G8_BAR; if (hi) { G8_MMA(1, 0, At, B0); G8_MMA(1, 1, At, B1); } G8_BAR; G8_SCHED;
            G8_LDB(B0, 1, 0); G8_LDB(B1, 1, 1); G8_SCHED; G8_LDA(At, 1, 0); G8_STAGEA(G8_SA(0, 1), a2, 1, p10, p11);
            G8_WAIT_V(8); G8_WAIT_L(0); G8_BAR; G8_MMA(0, 0, At, B0); G8_MMA(0, 1, At, B1); G8_BAR; G8_SCHED;
            G8_LDA(At, 1, 1); G8_STAGEB(G8_SB(1, 0), b3); G8_STAGEB(G8_SB(1, 1), b3 + hstepB); G8_STAGEA(G8_SA(1, 0), a3, 0, p00, p01);
            G8_WAIT_V(8); G8_WAIT_L(0); G8_BAR; if (hi) { G8_MMA(1, 0, At, B0); G8_MMA(1, 1, At, B1); } G8_BAR; G8_SCHED;
        }
        if (wr == 0) G8_BAR;
        const int te_ = opaque_tid(); const int fr_ = te_ & 15, fq_ = (te_ >> 4) & 3;
        const bool keep = E(acc, cur, wr, wc, fr_, fq_);
        if (!has_next) break;
        if (!keep) {
#pragma unroll
            for (int a = 0; a < 2; ++a)
#pragma unroll
                for (int b = 0; b < 2; ++b)
#pragma unroll
                    for (int m = 0; m < 4; ++m)
#pragma unroll
                        for (int n = 0; n < 2; ++n) acc[a][b][m][n] = (f32x4){0.f, 0.f, 0.f, 0.f};
        }
        cur = nxt; cA = nA; cB = nB; ++ui;
#pragma unroll
        for (int h = 0; h < 2; ++h)
#pragma unroll
            for (int i = 0; i < 2; ++i) oA[h][i] = nA_[h][i];
        if (wr == 1) G8_BAR;
    }
    G8_WAIT_V(0);
    G8_BAR;
#undef G8_SA
#undef G8_SB
#undef G8_STAGE
#undef G8_STAGEB
#undef G8_STAGEA
#undef G8_LDA
#undef G8_LDB
#undef G8_MMA
#undef G8_WAIT_V
#undef G8_WAIT_L
#undef G8_BAR
#undef G8_SCHED
}

struct DenseSched {
    static constexpr bool kGather = false;
    unsigned A, B; int nM, nN, nwg, G, c; unsigned tstep;
    DI void init(size_t A_, size_t B_, int M, int N, int K) { A = (unsigned)A_; B = (unsigned)B_; nM = M / 256; nN = N / 256; nwg = nM * nN; G = gridDim.x; c = blockIdx.x; tstep = 256u * (unsigned)K * 2u; }
    DI void tile(int L, int& pm, int& pn) const {
        const int wgid = xcd_remap(L, nwg);
        const int nig = 8 * nN, gid = wgid / nig, fm = gid * 8, gsz = (nM - fm) < 8 ? (nM - fm) : 8;
        pm = fm + ((wgid % nig) % gsz); pn = (wgid % nig) / gsz;
    }
    DI bool next(int i, GUnit& u) const {
        const long L = (long)i * G + c; if (L >= nwg) return false;
        tile((int)L, u.pm, u.pn); u.A = A + (unsigned)u.pm * tstep; u.B = B + (unsigned)u.pn * tstep; u.x0 = 0; u.x1 = 0; return true;
    }
    DI void aoffs(const GUnit&, int tid, int K, unsigned (&o)[2][2]) const {
        int R[2], C[2]; stage_rc(tid * 16, R[0], C[0]); stage_rc(tid * 16 + 8192, R[1], C[1]);
#pragma unroll
        for (int h = 0; h < 2; ++h)
#pragma unroll
            for (int i = 0; i < 2; ++i) o[h][i] = (unsigned)((128 * h + R[i]) * K + C[i]) * 2u;
    }
};
struct PairSched : DenseSched {
    unsigned A1, B1;
    DI bool next(int i, GUnit& u) const {
        const long L = (long)(i >> 1) * G + c; if (L >= nwg) return false;
        tile((int)L, u.pm, u.pn); const int st = i & 1;
        u.A = (st ? A1 : A) + (unsigned)u.pm * tstep; u.B = (st ? B1 : B) + (unsigned)u.pn * tstep; u.x0 = st; u.x1 = 0; return true;
    }
};
struct MoeSched {
    static constexpr bool kGather = true;
    unsigned X, Wr, Ws; const int* TE; const int* TR0; const int* TNH; const int* RT;
    int ntr, ncol, nunits, G, c, K; unsigned wexp, wtile; bool gather;
    DI bool next(int i, GUnit& u) const {
        const long L = (long)i * G + c; if (L >= nunits) return false;
        const int wgid = xcd_remap((int)L, nunits), ti = wgid / ncol; u.pn = wgid % ncol;
        if (ti < ntr) { const int e = TE[ti]; u.x0 = TR0[ti]; u.x1 = TNH[ti]; u.pm = -1; u.B = Wr + (unsigned)e * wexp + (unsigned)u.pn * wtile; u.A = gather ? X : X + (unsigned)u.x0 * (unsigned)K * 2u; }
        else { const int st = ti - ntr; u.x0 = MAXROWS + 256 * st; u.x1 = 2; u.pm = st; u.B = Ws + (unsigned)u.pn * wtile; u.A = gather ? X + (unsigned)st * 256u * (unsigned)K * 2u : X + (unsigned)u.x0 * (unsigned)K * 2u; }
        return true;
    }
    DI void aoffs(const GUnit& u, int tid, int K_, unsigned (&o)[2][2]) const {
        int R[2], C[2]; stage_rc(tid * 16, R[0], C[0]); stage_rc(tid * 16 + 8192, R[1], C[1]);
        if (gather && u.pm < 0) {
#pragma unroll
            for (int h = 0; h < 2; ++h)
#pragma unroll
                for (int i = 0; i < 2; ++i) o[h][i] = (unsigned)(RT[u.x0 + 128 * h + R[i]] * K_ + C[i]) * 2u;
        } else {
#pragma unroll
            for (int h = 0; h < 2; ++h)
#pragma unroll
                for (int i = 0; i < 2; ++i) o[h][i] = (unsigned)((128 * h + R[i]) * K_ + C[i]) * 2u;
        }
    }
};

struct EpiProj {
    const Params* pp; int l; float ds;
    DI bool operator()(f32x4 (&acc)[2][2][4][2], const GUnit& u, int wr, int wc, int fr, int fq) const {
        const Params& p = *pp; char* R = p.ws + O_R;
        const int pn = u.pn;
        const float* bias = (const float*)(p.ws + O_BIASP) + (size_t)l * NP + pn * 256 + 32 * wc + 8 * fq;
        f32x4 bv[2][2];
#pragma unroll
        for (int bj = 0; bj < 2; ++bj)
#pragma unroll
            for (int n = 0; n < 2; ++n) bv[bj][n] = *(const f32x4*)(bias + 128 * bj + 4 * n);
        int kind, head = 0, H = 8; bf16_t* dst = nullptr;
        if (pn < 2) { kind = 0; head = 4 * pn + wc; }
        else if (pn < 5) { H = 2; head = wc & 1; const bool isv = wc >= 2; kind = (isv || pn == 2) ? 1 : 2;
            const size_t off = pn == 2 ? (isv ? R_VC : R_KC) : pn == 3 ? (isv ? R_VS : R_KS) : (isv ? R_VW : R_KW); dst = (bf16_t*)(R + off); }
        else if (pn < 11) { const int sec = (pn - 5) >> 1; head = 4 * ((pn - 5) & 1) + wc; kind = sec == 2 ? 1 : 2; dst = (bf16_t*)(R + (sec == 0 ? R_QB : sec == 1 ? R_KB : R_VB)); }
        else if (pn < 19) { kind = 3; dst = (bf16_t*)(R + R_MA); head = (pn - 11) * 128; }
        else kind = 4;
        const float qs = (pn < 2 || pn == 5 || pn == 6) ? SM_C : 1.0f;
        const float* COS = (const float*)(p.ws + O_COS); const float* SIN = (const float*)(p.ws + O_SIN);
#pragma unroll
        for (int ai = 0; ai < 2; ++ai)
#pragma unroll
            for (int m = 0; m < 4; ++m) {
                const int t = u.pm * 256 + 128 * ai + 64 * wr + 16 * m + fr, b = t >> 12, s = t & 4095;
                f32x4 lo[2], hi[2];
#pragma unroll
                for (int n = 0; n < 2; ++n) { lo[n] = (acc[ai][0][m][n] * ds + bv[0][n]) * qs; hi[n] = (acc[ai][1][m][n] * ds + bv[1][n]) * qs; }
                if (kind <= 2) {
                    const size_t o = ((size_t)((b * H + head) * SEQ + s)) * 64 + 8 * fq;
                    if (kind == 0 || kind == 2) {
                        f32x4 rl[2], rh[2];
#pragma unroll
                        for (int n = 0; n < 2; ++n) { const f32x4 cs = *(const f32x4*)(COS + s * 32 + 4 * n + 8 * fq), sn = *(const f32x4*)(SIN + s * 32 + 4 * n + 8 * fq);
                            rl[n] = lo[n] * cs - hi[n] * sn; rh[n] = hi[n] * cs + lo[n] * sn; }
                        if (kind == 0) { bf16_t* qa = (bf16_t*)(R + R_QA) + o; bf16_t* qar = (bf16_t*)(R + R_QAR) + o;
#pragma unroll
                            for (int n = 0; n < 2; ++n) { st_bf16x4e(qa + 4 * n, lo[n]); st_bf16x4e(qa + 32 + 4 * n, hi[n]); st_bf16x4e(qar + 4 * n, rl[n]); st_bf16x4e(qar + 32 + 4 * n, rh[n]); } }
                        else {
#pragma unroll
                            for (int n = 0; n < 2; ++n) { st_bf16x4e(dst + o + 4 * n, rl[n]); st_bf16x4e(dst + o + 32 + 4 * n, rh[n]); } }
                    } else {
#pragma unroll
                        for (int n = 0; n < 2; ++n) { st_bf16x4e(dst + o + 4 * n, lo[n]); st_bf16x4e(dst + o + 32 + 4 * n, hi[n]); }
                    }
                } else if (kind == 3) {
                    unsigned char* o = (unsigned char*)dst + (size_t)t * D + head + 32 * wc + 8 * fq;
                    int r0 = 0, r1 = 0, b0 = 0, b1 = 0; float rr[8], sb[8];
#pragma unroll
                    for (int n = 0; n < 2; ++n)
#pragma unroll
                        for (int q = 0; q < 4; ++q) { const float ea = __expf(-lo[n][q]), eb = __expf(-hi[n][q]); sb[4 * n + q] = frcp(1.0f + eb); rr[4 * n + q] = fminf((1.0f + eb) * frcp(1.0f + ea), 400.0f); }
                    r0 = __builtin_amdgcn_cvt_pk_fp8_f32(rr[0], rr[1], r0, false); r0 = __builtin_amdgcn_cvt_pk_fp8_f32(rr[2], rr[3], r0, true);
                    r1 = __builtin_amdgcn_cvt_pk_fp8_f32(rr[4], rr[5], r1, false); r1 = __builtin_amdgcn_cvt_pk_fp8_f32(rr[6], rr[7], r1, true);
                    b0 = __builtin_amdgcn_cvt_pk_fp8_f32(sb[0], sb[1], b0, false); b0 = __builtin_amdgcn_cvt_pk_fp8_f32(sb[2], sb[3], b0, true);
                    b1 = __builtin_amdgcn_cvt_pk_fp8_f32(sb[4], sb[5], b1, false); b1 = __builtin_amdgcn_cvt_pk_fp8_f32(sb[6], sb[7], b1, true);
                    u32x2 wr_; wr_.x = (unsigned)r0; wr_.y = (unsigned)r1; u32x2 wb_; wb_.x = (unsigned)b0; wb_.y = (unsigned)b1;
                    *(u32x2*)o = wr_; *(u32x2*)(o + (R_MB - R_MA)) = wb_;
                } else if (wc == 0) {
                    float* ga = (float*)(R + R_GA) + (size_t)t * 24;
#pragma unroll
                    for (int n = 0; n < 2; ++n)
#pragma unroll
                        for (int q = 0; q < 4; ++q) { const int cidx = 4 * n + 8 * fq + q; if (cidx < 24) ga[cidx] = sigmoidf_(lo[n][q]); }
                }
            }
        return false;
    }
};
DI void phase_proj8(const Params& p, int l, LAS char* lds) {
    const int tid = opaque_tid();
    if (blockIdx.x < 2 && tid < 128) {
        const int lw = 2 * l + blockIdx.x; const float* PART = (const float*)(p.ws + O_C1PART) + (size_t)lw * 64 * 128;
        float a = p.in[I_CB1][lw * 128 + tid];
        for (int kq = 0; kq < 64; ++kq) a += PART[kq * 128 + tid];
        ((float*)(p.ws + O_C1))[lw * 128 + tid] = a;
    }
    constexpr int Kb = F8_P1 ? D / 2 : D;
    DenseSched S; S.init(F8_P1 ? O_XA8 : (l == 0 ? O_XB0 : O_XB1), O_WIN + (size_t)l * NP * Kb * 2, NT, NP, Kb);
    EpiProj E{&p, l, F8_P1 ? 1.0f / (XS8 * WS8) : 1.0f};
    gemm8<F8_P1>(lds, p.ws, Kb, S, E, tid);
}
DI void fp8x8_to_f32(const u32x2 w, float (&g)[8]) {
    const f32x2 a0 = __builtin_amdgcn_cvt_pk_f32_fp8((int)w.x, false), a1 = __builtin_amdgcn_cvt_pk_f32_fp8((int)w.x, true), a2 = __builtin_amdgcn_cvt_pk_f32_fp8((int)w.y, false), a3 = __builtin_amdgcn_cvt_pk_f32_fp8((int)w.y, true);
    g[0] = a0.x; g[1] = a0.y; g[2] = a1.x; g[3] = a1.y; g[4] = a2.x; g[5] = a2.y; g[6] = a3.x; g[7] = a3.y;
}
struct EpiMerge {
    const unsigned char* RT8; const unsigned char* MB8; bf16_t* MG; unsigned char* MG8; float ds;
    DI bool operator()(f32x4 (&acc)[2][2][4][2], const GUnit& u, int wr, int wc, int fr, int fq) const {
        const int st = u.x0; const unsigned char* G8 = st == 0 ? RT8 : MB8;
#pragma unroll
        for (int ai = 0; ai < 2; ++ai)
#pragma unroll
            for (int m = 0; m < 4; ++m) {
                const size_t o = (size_t)(u.pm * 256 + 128 * ai + 64 * wr + 16 * m + fr) * D + u.pn * 256 + 32 * wc + 8 * fq;
#pragma unroll
                for (int bj = 0; bj < 2; ++bj) {
                    float g[8]; fp8x8_to_f32(*(const u32x2*)(G8 + o + 128 * bj), g);
                    if (st == 0) {
#pragma unroll
                        for (int q = 0; q < 4; ++q) { acc[ai][bj][m][0][q] *= g[q]; acc[ai][bj][m][1][q] *= g[4 + q]; }
                    } else {
                        f32x4 v0, v1;
#pragma unroll
                        for (int q = 0; q < 4; ++q) { v0[q] = acc[ai][bj][m][0][q] * g[q] * ds; v1[q] = acc[ai][bj][m][1][q] * g[4 + q] * ds; }
                        if (F8_P6) { u32x2 w8; w8.x = pk4_fp8(v0[0], v0[1], v0[2], v0[3]); w8.y = pk4_fp8(v1[0], v1[1], v1[2], v1[3]); *(u32x2*)(MG8 + o + 128 * bj) = w8; }
                        else { st_bf16x4e(MG + o + 128 * bj, v0); st_bf16x4e(MG + o + 128 * bj + 4, v1); }
                    }
                }
            }
        return st == 0;
    }
};
DI void phase_projab8(const Params& p, int l, LAS char* lds) {
    const int tid = opaque_tid(); char* R = p.ws + O_R;
    constexpr int Kb = F8_P5 ? 256 : 512;
    PairSched S; S.init(F8_P5 ? O_OA8 : O_R + R_OA, O_WPA + (size_t)l * D * Kb * 2, NT, D, Kb);
    S.A1 = (unsigned)(F8_P5 ? O_OB8 : O_R + R_OB); S.B1 = (unsigned)(O_WPB + (size_t)l * D * Kb * 2);
    EpiMerge E{(const unsigned char*)(R + R_MA), (const unsigned char*)(R + R_MB), (bf16_t*)(R + R_MERGED), (unsigned char*)(p.ws + O_MG8), (F8_P6 ? MS8 : 1.0f) / (F8_P5 ? OS8 * WS8 : 1.0f)};
    gemm8<F8_P5>(lds, p.ws, Kb, S, E, tid);
}
struct EpiWout {
    const bf16_t* xin; bf16_t* Y; float ds;
    DI bool operator()(f32x4 (&acc)[2][2][4][2], const GUnit& u, int wr, int wc, int fr, int fq) const {
#pragma unroll
        for (int ai = 0; ai < 2; ++ai)
#pragma unroll
            for (int m = 0; m < 4; ++m) {
                const size_t o = (size_t)(u.pm * 256 + 128 * ai + 64 * wr + 16 * m + fr) * D + u.pn * 256 + 32 * wc + 8 * fq;
#pragma unroll
                for (int bj = 0; bj < 2; ++bj)
#pragma unroll
                    for (int n = 0; n < 2; ++n) { const s16x4 xb = *(const s16x4*)(xin + o + 128 * bj + 4 * n); f32x4 v;
#pragma unroll
                        for (int q = 0; q < 4; ++q) v[q] = bf2f((unsigned short)xb[q]) * ALPHA + acc[ai][bj][m][n][q] * ds;
                        st_bf16x4e(Y + o + 128 * bj + 4 * n, v); }
            }
        return false;
    }
};
DI void phase_wout8(const Params& p, int l, LAS char* lds) {
    const int tid = opaque_tid(); char* R = p.ws + O_R;
    constexpr int Kb = F8_P6 ? D / 2 : D;
    DenseSched S; S.init(F8_P6 ? O_MG8 : O_R + R_MERGED, O_WOUT + (size_t)l * D * Kb * 2, NT, D, Kb);
    EpiWout E{(const bf16_t*)(p.ws + (l == 0 ? O_XB0 : O_XB1)), (bf16_t*)(R + R_YPRE), F8_P6 ? 1.0f / (MS8 * WS8) : 1.0f};
    gemm8<F8_P6>(lds, p.ws, Kb, S, E, tid);
}
struct EpiLogit {
    float* LG;
    DI bool operator()(f32x4 (&acc)[2][2][4][2], const GUnit& u, int wr, int wc, int fr, int fq) const {
#pragma unroll
        for (int ai = 0; ai < 2; ++ai)
#pragma unroll
            for (int m = 0; m < 4; ++m) {
                const size_t o = (size_t)(u.pm * 256 + 128 * ai + 64 * wr + 16 * m + fr) * NE + 32 * wc + 8 * fq;
#pragma unroll
                for (int bj = 0; bj < 2; ++bj)
#pragma unroll
                    for (int n = 0; n < 2; ++n) st_f32x4e(LG + o + 128 * bj + 4 * n, acc[ai][bj][m][n]);
            }
        return false;
    }
};
DI void phase_router8(const Params& p, int l, LAS char* lds) {
    const int tid = opaque_tid();
    DenseSched S; S.init(O_XB1, O_WR + (size_t)l * NE * D * 2, NT, NE, D);
    EpiLogit E{(float*)(p.ws + O_LOGIT)};
    gemm8<false>(lds, p.ws, D, S, E, tid);
}
struct EpiSwiglu {
    bf16_t* H; float ds;
    DI bool operator()(f32x4 (&acc)[2][2][4][2], const GUnit& u, int wr, int wc, int fr, int fq) const {
#pragma unroll
        for (int ai = 0; ai < 2; ++ai) if (ai < u.x1) {
#pragma unroll
            for (int m = 0; m < 4; ++m) {
                bf16_t* hr = H + (size_t)(u.x0 + 128 * ai + 64 * wr + 16 * m + fr) * DE + u.pn * 128 + 32 * wc + 8 * fq;
                f32x4 hv[2];
#pragma unroll
                for (int n = 0; n < 2; ++n) { const f32x4 gv = acc[ai][0][m][n] * ds, uv = acc[ai][1][m][n] * ds;
#pragma unroll
                    for (int q = 0; q < 4; ++q) hv[n][q] = gv[q] * frcp(1.0f + __expf(-gv[q])) * uv[q]; }
                if (F8_M2) { u32x2 w8; w8.x = pk4_fp8(hv[0][0] * HS8, hv[0][1] * HS8, hv[0][2] * HS8, hv[0][3] * HS8); w8.y = pk4_fp8(hv[1][0] * HS8, hv[1][1] * HS8, hv[1][2] * HS8, hv[1][3] * HS8);
                    *(u32x2*)((unsigned char*)H + (size_t)(u.x0 + 128 * ai + 64 * wr + 16 * m + fr) * DE + u.pn * 128 + 32 * wc + 8 * fq) = w8; }
                else { st_bf16x4e(hr, hv[0]); st_bf16x4e(hr + 4, hv[1]); }
            }
        }
        return false;
    }
};
struct EpiDown {
    unsigned char* Y; int var; float ds;
    DI bool operator()(f32x4 (&acc)[2][2][4][2], const GUnit& u, int wr, int wc, int fr, int fq) const {
#pragma unroll
        for (int ai = 0; ai < 2; ++ai) if (ai < u.x1) {
#pragma unroll
            for (int mp = 0; mp < 2; ++mp) {
                unsigned char* yr = Y + (size_t)(u.x0 + 128 * ai + 64 * wr + 16 * (2 * mp + (fq & 1)) + fr) * D + u.pn * 256 + 32 * wc + 16 * (fq >> 1);
#pragma unroll
                for (int bj = 0; bj < 2; ++bj) {
                    u32x2 w[2];
#pragma unroll
                    for (int k = 0; k < 2; ++k) { const f32x4 v0 = acc[ai][bj][2 * mp + k][0] * ds, v1 = acc[ai][bj][2 * mp + k][1] * ds;
                        w[k].x = pk4_fp8(v0[0], v0[1], v0[2], v0[3]); w[k].y = pk4_fp8(v1[0], v1[1], v1[2], v1[3]); }
                    const u32x4 o = widen16(w[0], w[1]);
                    if (var == 2) { const int wv_ = wr * 4 + wc, ii = (ai * 2 + mp) * 2 + bj; *(u32x4*)(Y + (size_t)u.x0 * D + u.pn * 65536 + wv_ * 8192 + ii * 1024 + (fq * 16 + fr) * 16) = o; }
                    else if (var != 1) *(u32x4*)(yr + 128 * bj) = o; else asm volatile("" :: "v"(o));
                }
            }
        }
        return false;
    }
};
DI void phase_moe1_8(const Params& p, int l, LAS char* lds) {
    const int tid = opaque_tid();
    constexpr int Kb = F8_M1 ? D / 2 : D;
    MoeSched S; S.X = (unsigned)(F8_M1 ? O_XA8 : O_XB1); S.Wr = (unsigned)(O_WGU + (size_t)l * NE * 512 * D); S.Ws = (unsigned)(O_WSGU + (size_t)l * 512 * Kb * 2);
    S.TE = (const int*)(p.ws + O_TILEE); S.TR0 = S.TE + 1408; S.TNH = S.TE + 2816; S.RT = (const int*)(p.ws + O_ROWTOK);
    S.ntr = ((const int*)(p.ws + O_MISC))[l]; S.ncol = 2; S.nunits = (S.ntr + 128) * 2; S.G = gridDim.x; S.c = blockIdx.x; S.K = Kb;
    S.wexp = 512u * Kb * 2u; S.wtile = 256u * Kb * 2u; S.gather = true;
    EpiSwiglu E{(bf16_t*)(p.ws + O_H), F8_M1 ? 1.0f / (XS8 * WS8) : 1.0f};
    gemm8<F8_M1>(lds, p.ws, Kb, S, E, tid);
    conv_drain(p, (l + 1) * NQ0, lds, (volatile LAS unsigned*)(lds + LDS_BYTES), tid);
}
DI void phase_moe2_8(const Params& p, int l, LAS char* lds, int var = 0) {
    const int tid = opaque_tid();
    constexpr int Kb = F8_M2 ? DE / 2 : DE;
    MoeSched S; S.X = (unsigned)O_H; S.Wr = (unsigned)(O_WDN + (size_t)l * NE * D * DE); S.Ws = (unsigned)(O_WSD + (size_t)l * D * Kb * 2);
    S.TE = (const int*)(p.ws + O_TILEE); S.TR0 = S.TE + 1408; S.TNH = S.TE + 2816; S.RT = nullptr;
    S.ntr = ((const int*)(p.ws + O_MISC))[l]; S.ncol = 4; S.nunits = (S.ntr + 128) * 4; S.G = gridDim.x; S.c = blockIdx.x; S.K = Kb;
    S.wexp = (unsigned)D * Kb * 2u; S.wtile = 256u * Kb * 2u; S.gather = false;
    EpiDown E{(unsigned char*)(p.ws + O_R), var, F8_M2 ? 16.0f / (HS8 * WS8) : 16.0f};
    gemm8<F8_M2>(lds, p.ws, Kb, S, E, tid);
}
DI void phase_dispatch8(const Params& p, int l, LAS char* lds) {
    const int tid = opaque_tid();
    LAS int* sc = (LAS int*)lds;
    const unsigned* CNT = (const unsigned*)(p.ws + O_CNT) + l * NE;
    int pad = 0, ntl = 0;
    __syncthreads();
    if (tid < NE) { pad = ((int)CNT[tid] + 127) & ~127; ntl = (pad + 255) >> 8; sc[tid] = pad; sc[256 + tid] = ntl; }
    __syncthreads();
    for (int d = 1; d < NE; d <<= 1) {
        int v = 0, v2 = 0;
        if (tid < NE && tid >= d) { v = sc[tid - d]; v2 = sc[256 + tid - d]; }
        __syncthreads();
        if (tid < NE) { sc[tid] += v; sc[256 + tid] += v2; }
        __syncthreads();
    }
    if (blockIdx.x == 0 && tid < NE) {
        int* TE = (int*)(p.ws + O_TILEE); int* TR0 = TE + 1408; int* TNH = TE + 2816;
        const int pe = sc[tid], ps = pe - pad, te = sc[256 + tid], ts = te - ntl;
        for (int k = 0; k < ntl; ++k) { TE[ts + k] = tid; TR0[ts + k] = ps + 256 * k; TNH[ts + k] = (pe - (ps + 256 * k)) >= 256 ? 2 : 1; }
        if (tid == NE - 1) ((int*)(p.ws + O_MISC))[l] = te;
    }
    const int* TOPI = (const int*)(p.ws + O_TOPI); const int* POS = (const int*)(p.ws + O_POS); int* SLOT = (int*)(p.ws + O_SLOT); int* RT = (int*)(p.ws + O_ROWTOK);
    for (size_t a = (size_t)blockIdx.x * NTHREADS + tid; a < (size_t)NT * TOPK; a += (size_t)gridDim.x * NTHREADS) {
        const int e = TOPI[a]; const int ps = (e > 0) ? sc[e - 1] : 0;
        const int dest = ps + POS[a];
        RT[dest] = (int)(a >> 3); SLOT[a] = dest;
    }
    conv_drain(p, l * NQ0 + NQG, lds, (volatile LAS unsigned*)(lds + LDS_BYTES), tid);
}

constexpr int NPH = 14;
typedef const __attribute__((address_space(4))) Params* KParams;
DI Params load_params(KParams pk) { Params p;
#pragma unroll
    for (int i = 0; i < 22; ++i) p.in[i] = pk->in[i];
    p.out = pk->out; p.ws = pk->ws; return p; }
template <int PH> DI void run_phase(KParams pk, int l, LAS char* lds, int var = 0) {
    asm volatile("" : "+s"(pk));
    const Params p = load_params(pk);
    if constexpr (PH == 0) phase_prologue(p, lds);
    if constexpr (PH == 1) phase_proj8(p, l, lds);
    if constexpr (PH == 2) { phase_compress1(p, l, lds); if (blockIdx.x >= 32) { const int tid = opaque_tid(); for (int i = (int)blockIdx.x - 32; i < 16 * (64 - WIN_SPLIT); i += (int)gridDim.x - 32) nsa_win_unit(p, (i & 15) >> 1, i & 1, WIN_SPLIT + (i >> 4), lds, tid); } }
    if constexpr (PH == 3) { phase_compress2(p, l, lds);
#if MOBA_SPARSE
        if (var != 1) { const int tid = opaque_tid(); for (int u = blockIdx.x; u < 1024; u += gridDim.x) if ((u >> 6) > 0) moba_gate_unit(p, l, u & 63, u >> 6, lds, tid); }
#endif
    }
    if constexpr (PH == 4) phase_attention(p, l, lds);
    if constexpr (PH == 14) phase_moba_own(p, lds, var);
    if constexpr (PH == 5) phase_projab8(p, l, lds);
    if constexpr (PH == 6) phase_wout8(p, l, lds);
    if constexpr (PH == 7) phase_ln1(p, l);
    if constexpr (PH == 8) phase_router8(p, l, lds);
    if constexpr (PH == 9) phase_routing(p, l, lds, var);
    if constexpr (PH == 10) phase_dispatch8(p, l, lds);
    if constexpr (PH == 11) phase_moe1_8(p, l, lds);
    if constexpr (PH == 12) phase_moe2_8(p, l, lds, var);
    if constexpr (PH == 13) phase_combine(p, l, var);
}

DI void xcd_barrier_w(const XcdBarrier& b, KParams pk, LAS char* lds) {
    asm volatile("s_waitcnt vmcnt(0)" ::: "memory");
    __syncthreads();
    const int tid = opaque_tid();
    unsigned* bar = b.bar; unsigned bx = 0u, gen = 0u;
    volatile LAS unsigned* st = b.st;
    if (tid == 0) {
        bx = xb_xcc_id();
        __builtin_amdgcn_s_waitcnt(0);
        unsigned nloc = st[0], nx = st[1];
        if (nloc == 0u) { xcd_barrier_complete(bar, bx, nloc, nx); st[0] = nloc; st[1] = nx; }
        const unsigned old = xb_add(&bar[XB_XSUB(bx)], 1u);
        gen = old / nloc;
        if (old + 1u == (gen + 1u) * nloc) {
            __builtin_amdgcn_fence(__ATOMIC_RELEASE, "agent");
            asm volatile("s_waitcnt vmcnt(0)" ::: "memory");
            const unsigned og = xb_add(&bar[XB_TOP], 1u);
            const unsigned tg = og / nx;
            if (og + 1u == (tg + 1u) * nx) xb_add(&bar[XB_TOPGEN], 1u);
            else XB_SPIN(xb_ld(&bar[XB_TOPGEN]) == tg, bar);
            __builtin_amdgcn_fence(__ATOMIC_ACQUIRE, "agent");
            xb_add(&bar[XB_XGEN(bx)], 1u);
            asm volatile("s_waitcnt vmcnt(0)" ::: "memory");
            st[2] = 1u;
        } else st[2] = 0u;
    }
    __syncthreads();
    unsigned rel = st[2];
    __syncthreads();
    while (!rel) {
        if (tid == 0) {
            if (xb_ld(&bar[XB_XGEN(bx)]) != gen) { __builtin_amdgcn_fence(__ATOMIC_ACQUIRE, "agent"); asm volatile("s_waitcnt vmcnt(0)" ::: "memory"); st[2] = 1u; }
            else if (st[3] != 0xffffffffu) { const unsigned q = atomicAdd((unsigned*)(pk->ws + O_WQ), 1u); st[3] = q < (unsigned)NQ ? q : 0xffffffffu; }
            else { XB_SPIN(xb_ld(&bar[XB_XGEN(bx)]) == gen, bar); __builtin_amdgcn_fence(__ATOMIC_ACQUIRE, "agent"); asm volatile("s_waitcnt vmcnt(0)" ::: "memory"); st[2] = 1u; }
        }
        __syncthreads();
        rel = st[2];
        const unsigned q = st[3];
        __syncthreads();
        if (rel) break;
        if (q != 0xffffffffu) { const Params p = load_params(pk); conv_pair(p, (int)q, lds, tid); }
    }
    __syncthreads();
}

extern __shared__ __attribute__((aligned(16))) char dyn_smem[];

#if MK_MULTI
template <int PH> __global__ void __launch_bounds__(NTHREADS, 2) k_phase(Params p, int l) {
    (void)p; run_phase<PH>((KParams)__builtin_amdgcn_kernarg_segment_ptr(), l, (LAS char*)dyn_smem);
}

#else
__global__ void __launch_bounds__(NTHREADS, 2) k_mega(Params p) {
    LAS char* lds = (LAS char*)dyn_smem;
    LAS char* xbw = lds + LDS_BYTES;
    if (opaque_tid() == 0) *(LAS u32x4*)xbw = (u32x4){0u, 0u, 0u, 0u};
    __syncthreads();
    KParams pk = (KParams)__builtin_amdgcn_kernarg_segment_ptr();
    XcdBarrier bar = xcd_barrier_post((unsigned*)(pk->ws + O_BAR), (volatile LAS unsigned*)xbw);
#define RUNP(PH) do { run_phase<PH>(pk, l, lds); if (PROBE_DUP == PH || (PROBE_DUP == 201 && (PH == 2 || PH == 3)) || (PROBE_DUP == 202 && (PH == 5 || PH == 6)) || (PROBE_DUP == 203 && (PH == 7 || PH == 8 || PH == 10)) || (PROBE_DUP == 204 && PH == 13)) { for (int rep = 0; rep < NREP; ++rep) { xcd_barrier(bar); run_phase<PH>(pk, l, lds, PROBE_VAR); } } } while (0)
    { const int l = 0; run_phase<0>(pk, l, lds); if (PROBE_DUP == 100) { for (int rep = 0; rep < NREP; ++rep) { xcd_barrier(bar); run_phase<0>(pk, l, lds); } } }
    xcd_barrier_w(bar, pk, lds);
#define LAYER(LL, LASTL) do { const int l = LL; \
        RUNP(1); xcd_barrier_w(bar, pk, lds); \
        RUNP(2); xcd_barrier_w(bar, pk, lds); \
        RUNP(3); xcd_barrier_w(bar, pk, lds); \
        RUNP(4); \
        if (PROBE_DUP == 41) { for (int rep = 0; rep < NREP; ++rep) { xcd_barrier(bar); const Params pq = load_params(pk); phase_attention(pq, l, lds, 1); } } \
        if (PROBE_DUP == 42) { for (int rep = 0; rep < NREP; ++rep) { xcd_barrier(bar); const Params pq = load_params(pk); phase_attention(pq, l, lds, 2); } } \
        if (PROBE_DUP == 400) { for (int rep = 0; rep < NREP; ++rep) { xcd_barrier(bar); run_phase<2>(pk, l, lds); xcd_barrier(bar); const Params pq = load_params(pk); phase_attention(pq, l, lds, 1); } } \
        xcd_barrier_w(bar, pk, lds); \
        if (MOBA_SPARSE && PROBE_DUP == 140) { for (int rep = 0; rep < NREP; ++rep) { run_phase<14>(pk, l, lds, PROBE_VAR); xcd_barrier(bar); } } \
        if (MOBA_SPARSE) { RUNP(14); xcd_barrier_w(bar, pk, lds); } \
        RUNP(5); xcd_barrier_w(bar, pk, lds); \
        RUNP(6); xcd_barrier_w(bar, pk, lds); \
        RUNP(7); xcd_barrier_w(bar, pk, lds); \
        if (PROBE_DUP == 300) { for (int rep = 0; rep < 2 * NREP; ++rep) xcd_barrier(bar); } \
        RUNP(8); xcd_barrier_w(bar, pk, lds); \
        run_phase<9>(pk, l, lds); if (PROBE_DUP == 9) { for (int rep = 0; rep < NREP; ++rep) { xcd_barrier(bar); run_phase<9>(pk, l, lds, 1); } } xcd_barrier_w(bar, pk, lds); \
        RUNP(10); xcd_barrier_w(bar, pk, lds); \
        RUNP(11); xcd_barrier_w(bar, pk, lds); \
        if (PROBE_DUP == 120) { for (int rep = 0; rep < NREP; ++rep) { run_phase<12>(pk, l, lds, 2); xcd_barrier(bar); } } \
        RUNP(12); xcd_barrier_w(bar, pk, lds); \
        RUNP(13); \
        if (!(LASTL)) xcd_barrier_w(bar, pk, lds); } while (0)
    LAYER(0, false);
    LAYER(1, true);
}
#endif
#if MK_MULTI
template <int PH> static void launch_phase(const Params& p, int l, int grid, hipStream_t stream) {
    static bool attr = false;
    if (!attr) { (void)hipFuncSetAttribute((const void*)k_phase<PH>, hipFuncAttributeMaxDynamicSharedMemorySize, LDS_BYTES + 16); attr = true; }
    hipLaunchKernelGGL(k_phase<PH>, dim3(grid), dim3(NTHREADS), LDS_BYTES + 16, stream, p, l);
}

#endif
extern "C" void kernel_launch(void* const* d_in, const int* in_sizes, int n_in, void* d_out, int out_size, void* d_ws, size_t ws_size, hipStream_t stream) {
    (void)in_sizes; (void)n_in; (void)out_size; (void)ws_size;
    Params p{};
    for (int i = 0; i < 22; ++i) p.in[i] = (const float*)d_in[i];
    p.out = (float*)d_out; p.ws = (char*)d_ws;
    static int grid = 0;
    if (!grid) {
        int dev = 0, cus = 0; (void)hipGetDevice(&dev); (void)hipDeviceGetAttribute(&cus, hipDeviceAttributeMultiprocessorCount, dev);
        if (cus <= 0) cus = 256;
        grid = cus;
    }
    (void)hipMemsetAsync(d_ws, 0, ZERO_BYTES, stream);
#if MK_MULTI
    launch_phase<0>(p, 0, grid, stream);
    for (int l = 0; l < NL; ++l) {
        launch_phase<1>(p, l, grid, stream); launch_phase<2>(p, l, grid, stream); launch_phase<3>(p, l, grid, stream); launch_phase<4>(p, l, grid, stream);
        launch_phase<5>(p, l, grid, stream); launch_phase<6>(p, l, grid, stream); launch_phase<7>(p, l, grid, stream); launch_phase<8>(p, l, grid, stream);
        launch_phase<9>(p, l, grid, stream); launch_phase<10>(p, l, grid, stream); launch_phase<11>(p, l, grid, stream); launch_phase<12>(p, l, grid, stream);
        launch_phase<13>(p, l, grid, stream);
    }
#else
    static bool attr = false;
    if (!attr) {
        (void)hipFuncSetAttribute((const void*)k_mega, hipFuncAttributeMaxDynamicSharedMemorySize, LDS_BYTES + 16);
        int per_cu = 0; (void)hipOccupancyMaxActiveBlocksPerMultiprocessor(&per_cu, (const void*)k_mega, NTHREADS, LDS_BYTES + 16);
        if (per_cu < 1) fprintf(stderr, "k_mega: occupancy query says %d blocks per CU\n", per_cu);
        attr = true;
    }
    hipLaunchKernelGGL(k_mega, dim3(grid), dim3(NTHREADS), LDS_BYTES + 16, stream, p);
#endif
}
```
